# Optimizing an MI355X kernel written in HIP

```python
import math
import jax, jax.numpy as jnp
from jax import lax
import numpy as np

D_MODEL = 1024
BATCH = 8
SEQ = 4096
DEPTH = 4

GDN_HEADS = 4
GDN_HEAD_DIM = 128
CONV_WIDTH = 4
GDN_CHUNK = 64
DIFF_HEADS = 4
DIFF_QK_DIM = 64
DIFF_V_DIM = 2 * DIFF_QK_DIM
FOX_HEADS = 8
FOX_HEAD_DIM = D_MODEL // FOX_HEADS
D_FF = 4 * D_MODEL
PLE_DIM = 256
ROPE_THETA = 10000.0
Q_BLOCK = 128
EPS = 1e-6
NEG_INF = -1e30

N_EVEN = (DEPTH + 1) // 2
N_ODD = DEPTH // 2

GDN_QK = GDN_HEADS * GDN_HEAD_DIM
GDN_V = GDN_HEADS * GDN_HEAD_DIM
DIFF_Q = DIFF_HEADS * 2 * DIFF_QK_DIM
DIFF_V = DIFF_HEADS * DIFF_V_DIM
EVEN_SPLITS = [3 * GDN_QK, GDN_V, GDN_HEADS, GDN_HEADS, DIFF_Q, DIFF_Q, DIFF_V]
EVEN_IN = sum(EVEN_SPLITS)
EVEN_MIX = GDN_V + DIFF_V
ODD_MIX = FOX_HEADS * FOX_HEAD_DIM
ODD_SPLITS = [ODD_MIX, ODD_MIX, ODD_MIX, ODD_MIX, FOX_HEADS]
ODD_IN = sum(ODD_SPLITS)

kernel_name = 'hybrid_gdn_diffattn_fox_trunk'


def split_cols(t, sizes):
    offs = np.concatenate([[0], np.cumsum(sizes)]).tolist()
    return [t[..., offs[i]:offs[i + 1]] for i in range(len(sizes))]


def rms_norm(x, w):
    xf = x.astype(jnp.float32)
    y = xf * lax.rsqrt(jnp.mean(xf * xf, axis=-1, keepdims=True) + EPS)
    return (y * w.astype(jnp.float32)).astype(x.dtype)


def l2_norm(x):
    return x * lax.rsqrt(jnp.sum(x * x, axis=-1, keepdims=True) + EPS)


def rope_tables(positions, dim):
    inv_freq = ROPE_THETA ** (-jnp.arange(0, dim, 2, dtype=jnp.float32) / dim)
    ang = positions.astype(jnp.float32)[..., None] * inv_freq
    return jnp.cos(ang), jnp.sin(ang)


def apply_rope(x, cos, sin):
    shape = cos.shape[:2] + (1,) * (x.ndim - 3) + cos.shape[2:]
    c, s = cos.reshape(shape), sin.reshape(shape)
    x1, x2 = jnp.split(x.astype(jnp.float32), 2, axis=-1)
    return jnp.concatenate([x1 * c - x2 * s, x2 * c + x1 * s], axis=-1)


def causal_conv(x, w):
    K = w.shape[0]
    T = x.shape[1]
    xp = jnp.pad(x, ((0, 0), (K - 1, 0), (0, 0)))
    return sum(xp[:, i:i + T] * w[i] for i in range(K))


def causal_mask(start, T):
    return (start + jnp.arange(Q_BLOCK))[:, None] >= jnp.arange(T)[None, :]


def block_starts(T):
    return jnp.arange(T // Q_BLOCK) * Q_BLOCK


def gated_delta_rule(q, k, v, g, beta):
    B, H, T, dk = q.shape
    dv = v.shape[-1]
    C = GDN_CHUNK
    N = T // C
    chunk = lambda t: t.reshape(B, H, N, C, *t.shape[3:])
    q = chunk(q * dk ** -0.5)
    k = chunk(k)
    v = chunk(v)
    beta = chunk(beta)
    gc = jnp.cumsum(chunk(g), axis=-1)
    incl = jnp.tril(jnp.ones((C, C), dtype=bool))
    strict = jnp.tril(jnp.ones((C, C), dtype=bool), -1)
    decay = jnp.where(incl, jnp.exp(jnp.where(incl, gc[..., :, None] - gc[..., None, :], 0.0)), 0.0)
    kb = k * beta[..., None]
    kk = jnp.einsum('bhncd,bhnsd->bhncs', kb, k) * decay
    a_mat = jnp.where(strict, kk, 0.0) + jnp.eye(C, dtype=kk.dtype)
    rhs = jnp.concatenate([v * beta[..., None], kb * jnp.exp(gc)[..., None]], axis=-1)
    sol = lax.linalg.triangular_solve(a_mat, rhs, left_side=True, lower=True, unit_diagonal=True)
    u, w = sol[..., :dv], sol[..., dv:]
    qk = jnp.where(incl, jnp.einsum('bhncd,bhnsd->bhncs', q, k) * decay, 0.0)
    q_dec = q * jnp.exp(gc)[..., None]
    k_dec = k * jnp.exp(gc[..., -1:] - gc)[..., None]
    g_last = jnp.exp(gc[..., -1])

    def step(S, xs):
        qd, kd, uc, wc, qkc, gl = xs
        v_new = uc - jnp.einsum('bhcd,bhde->bhce', wc, S)
        o = jnp.einsum('bhcd,bhde->bhce', qd, S) + jnp.einsum('bhcs,bhse->bhce', qkc, v_new)
        S = S * gl[..., None, None] + jnp.einsum('bhcd,bhce->bhde', kd, v_new)
        return S, o

    xs = tuple(jnp.moveaxis(t, 2, 0) for t in (q_dec, k_dec, u, w, qk, g_last))
    S0 = jnp.zeros((B, H, dk, dv), jnp.float32)
    _, o = lax.scan(step, S0, xs)
    return jnp.moveaxis(o, 0, 2).reshape(B, H, T, dv)


def diff_attention(q, k, v, lam):
    B, T, H, _, d = q.shape
    dv = v.shape[-1]
    qh = q.transpose(0, 2, 3, 1, 4).astype(jnp.float32) * d ** -0.5
    kh = k.transpose(0, 2, 3, 1, 4).astype(jnp.float32)
    vh = v.transpose(0, 2, 1, 3).astype(jnp.float32)

    def block(start):
        qb = lax.dynamic_slice_in_dim(qh, start, Q_BLOCK, axis=3)
        s = jnp.einsum('bhmqd,bhmkd->bhmqk', qb, kh)
        a = jax.nn.softmax(jnp.where(causal_mask(start, T), s, NEG_INF), axis=-1)
        a = a[:, :, 0] - lam * a[:, :, 1]
        return jnp.einsum('bhqk,bhkd->bhqd', a, vh)

    o = lax.map(block, block_starts(T))
    return o.transpose(1, 0, 3, 2, 4).reshape(B, T, H, dv)


def even_mixer(h, cos, sin, w_in, conv_w, a_log, dt_bias, gdn_norm_w,
               lam_q1, lam_k1, lam_q2, lam_k2, diff_norm_w, w_out, lambda_init):
    B, T, _ = h.shape
    qkv_a, z_a, b_a, a_a, q_b, k_b, v_b = split_cols(h @ w_in, EVEN_SPLITS)
    qkv_a = jax.nn.silu(causal_conv(qkv_a, conv_w))
    q_a, k_a, v_a = split_cols(qkv_a, [GDN_QK, GDN_QK, GDN_V])
    to_heads = lambda t: t.reshape(B, T, GDN_HEADS, GDN_HEAD_DIM).transpose(0, 2, 1, 3).astype(jnp.float32)
    q_a = l2_norm(to_heads(q_a))
    k_a = l2_norm(to_heads(k_a))
    v_a = to_heads(v_a)
    beta = jax.nn.sigmoid(b_a.astype(jnp.float32)).transpose(0, 2, 1)
    g = (-jnp.exp(a_log.astype(jnp.float32))
         * jax.nn.softplus(a_a.astype(jnp.float32) + dt_bias.astype(jnp.float32))).transpose(0, 2, 1)
    o_a = gated_delta_rule(q_a, k_a, v_a, g, beta).transpose(0, 2, 1, 3)
    z = z_a.reshape(B, T, GDN_HEADS, GDN_HEAD_DIM).astype(jnp.float32)
    o_a = rms_norm(o_a, gdn_norm_w) * jax.nn.silu(z)
    q_b = apply_rope(q_b.reshape(B, T, DIFF_HEADS, 2, DIFF_QK_DIM), cos, sin)
    k_b = apply_rope(k_b.reshape(B, T, DIFF_HEADS, 2, DIFF_QK_DIM), cos, sin)
    v_b = v_b.reshape(B, T, DIFF_HEADS, DIFF_V_DIM)
    lam = (jnp.exp(jnp.sum(lam_q1.astype(jnp.float32) * lam_k1.astype(jnp.float32)))
           - jnp.exp(jnp.sum(lam_q2.astype(jnp.float32) * lam_k2.astype(jnp.float32))) + lambda_init)
    o_b = diff_attention(q_b, k_b, v_b, lam)
    o_b = rms_norm(o_b, diff_norm_w) * (1.0 - lambda_init)
    o = jnp.concatenate([o_a.reshape(B, T, GDN_V), o_b.reshape(B, T, DIFF_V)], axis=-1)
    return o.astype(h.dtype) @ w_out


def fox_mixer(h, w_in, b_forget, w_out):
    B, T, _ = h.shape
    q, k, v, gate, f = split_cols(h @ w_in, ODD_SPLITS)
    heads = lambda t: t.reshape(B, T, FOX_HEADS, FOX_HEAD_DIM).transpose(0, 2, 1, 3).astype(jnp.float32)
    qh = heads(q) * FOX_HEAD_DIM ** -0.5
    kh = heads(k)
    vh = heads(v)
    log_f = jax.nn.log_sigmoid(f.astype(jnp.float32) + b_forget.astype(jnp.float32))
    cum = jnp.cumsum(log_f, axis=1).transpose(0, 2, 1)

    def block(start):
        qb = lax.dynamic_slice_in_dim(qh, start, Q_BLOCK, axis=2)
        cb = lax.dynamic_slice_in_dim(cum, start, Q_BLOCK, axis=2)
        s = jnp.einsum('bhqd,bhkd->bhqk', qb, kh) + cb[..., :, None] - cum[:, :, None, :]
        a = jax.nn.softmax(jnp.where(causal_mask(start, T), s, NEG_INF), axis=-1)
        return jnp.einsum('bhqk,bhkd->bhqd', a, vh)

    o = lax.map(block, block_starts(T))
    o = o.transpose(1, 0, 3, 2, 4).reshape(B, T, ODD_MIX)
    o = o * jax.nn.sigmoid(gate.astype(jnp.float32))
    return o.astype(h.dtype) @ w_out


def setup_inputs(seed: int = 0) -> dict:
    key = jax.random.key(seed)
    ks = jax.random.split(key, 32)
    nrm = lambda k, shape, scale: jax.random.normal(k, shape, jnp.float32) * scale
    gain = lambda k, shape: 1.0 + 0.02 * jax.random.normal(k, shape, jnp.float32)
    dt = jnp.exp(jax.random.uniform(ks[7], (N_EVEN, GDN_HEADS), jnp.float32,
                                    math.log(0.001), math.log(0.1)))
    res_scale = (2.0 * DEPTH) ** -0.5
    return {
        'x': nrm(ks[0], (BATCH, SEQ, D_MODEL), 1.0),
        'p': nrm(ks[1], (DEPTH, BATCH, SEQ, PLE_DIM), 1.0),
        'positions': jnp.broadcast_to(jnp.arange(SEQ, dtype=jnp.int32), (BATCH, SEQ)),
        'norm_mix': gain(ks[2], (DEPTH, D_MODEL)),
        'norm_mlp': gain(ks[3], (DEPTH, D_MODEL)),
        'norm_final': gain(ks[4], (D_MODEL,)),
        'w_in_even': nrm(ks[5], (N_EVEN, D_MODEL, EVEN_IN), D_MODEL ** -0.5),
        'conv_w': nrm(ks[6], (N_EVEN, CONV_WIDTH, 3 * GDN_QK), CONV_WIDTH ** -0.5),
        'a_log': jnp.log(jax.random.uniform(ks[8], (N_EVEN, GDN_HEADS), jnp.float32, 1.0, 16.0)),
        'dt_bias': dt + jnp.log(-jnp.expm1(-dt)),
        'gdn_norm': gain(ks[9], (N_EVEN, GDN_HEAD_DIM)),
        'lam_q1': nrm(ks[10], (N_EVEN, DIFF_QK_DIM), 0.1),
        'lam_k1': nrm(ks[11], (N_EVEN, DIFF_QK_DIM), 0.1),
        'lam_q2': nrm(ks[12], (N_EVEN, DIFF_QK_DIM), 0.1),
        'lam_k2': nrm(ks[13], (N_EVEN, DIFF_QK_DIM), 0.1),
        'diff_norm': gain(ks[14], (N_EVEN, DIFF_V_DIM)),
        'w_out_even': nrm(ks[15], (N_EVEN, EVEN_MIX, D_MODEL), EVEN_MIX ** -0.5 * res_scale),
        'w_in_odd': nrm(ks[16], (N_ODD, D_MODEL, ODD_IN), D_MODEL ** -0.5),
        'b_forget': jax.random.uniform(ks[17], (N_ODD, FOX_HEADS), jnp.float32, 1.0, 4.0),
        'w_out_odd': nrm(ks[18], (N_ODD, ODD_MIX, D_MODEL), ODD_MIX ** -0.5 * res_scale),
        'w_mlp_up': nrm(ks[19], (DEPTH, D_MODEL, D_FF), D_MODEL ** -0.5),
        'w_mlp_down': nrm(ks[20], (DEPTH, D_FF, D_MODEL), D_FF ** -0.5 * res_scale),
        'w_ple_proj': nrm(ks[21], (DEPTH, PLE_DIM, D_MODEL), PLE_DIM ** -0.5 * res_scale),
        'w_ple_gate': nrm(ks[22], (DEPTH, D_MODEL, D_MODEL), D_MODEL ** -0.5),
    }


def reference(x, p, positions, norm_mix, norm_mlp, norm_final, w_in_even, conv_w, a_log, dt_bias,
              gdn_norm, lam_q1, lam_k1, lam_q2, lam_k2, diff_norm, w_out_even, w_in_odd, b_forget,
              w_out_odd, w_mlp_up, w_mlp_down, w_ple_proj, w_ple_gate):
    cos, sin = rope_tables(positions, DIFF_QK_DIM)
    for i in range(DEPTH):
        j = i // 2
        h = rms_norm(x, norm_mix[i])
        if i % 2 == 0:
            lambda_init = 0.8 - 0.6 * math.exp(-0.3 * i)
            y = even_mixer(h, cos, sin, w_in_even[j], conv_w[j], a_log[j], dt_bias[j], gdn_norm[j],
                           lam_q1[j], lam_k1[j], lam_q2[j], lam_k2[j], diff_norm[j], w_out_even[j],
                           lambda_init)
        else:
            y = fox_mixer(h, w_in_odd[j], b_forget[j], w_out_odd[j])
        x = x + y
        h = rms_norm(x, norm_mlp[i])
        x = x + jnp.square(jax.nn.relu(h @ w_mlp_up[i])) @ w_mlp_down[i]
        x = x + (p[i] @ w_ple_proj[i]) * jax.nn.sigmoid(x @ w_ple_gate[i])
    return rms_norm(x, norm_final)
```

```cpp
#include <hip/hip_runtime.h>
#include <hip/hip_cooperative_groups.h>
#include <cstdio>
#include <cstdint>
#include <type_traits>
namespace cg = cooperative_groups;
namespace pg8 {
#define PG8_LAS __attribute__((address_space(3)))
typedef unsigned short bf16_t;
typedef short bf16x8 __attribute__((ext_vector_type(8)));
typedef float f32x4 __attribute__((ext_vector_type(4)));
typedef unsigned u32x4 __attribute__((ext_vector_type(4)));
constexpr int BM = 256, BK = 64, HALF = 128, HTB = HALF * BK * 2  , STAGE_BYTES = 8 * HTB, NXCD = 8, WGM = 8;

__host__ __device__ __forceinline__ int lds_byte(int r, int c) { const int st = (r >> 4) * 2 + (c >> 5), rr = r & 15, cc = c & 31, ob = rr * 64 + cc * 2; return st * 1024 + (ob ^ (((ob >> 9) & 1) << 5)); }
__host__ __device__ __forceinline__ void stage_rc(int b, int& R, int& C) { const int st = b / 1024, sb = b % 1024, swz = sb ^ (((sb >> 9) & 1) << 5); R = (st >> 1) * 16 + swz / 64; C = (st & 1) * 32 + (swz % 64) / 2; }
__host__ __device__ __forceinline__ int perm32(int rho) { const int n = rho >> 4, i = rho & 15; return 8 * (i >> 2) + 4 * n + (i & 3); }

struct Unit { int pm, pn; };
struct Gemm { const bf16_t* A; const bf16_t* Bt; int M, N, K; };

struct StaticOrder {
    int nM, nN, nwg, G, c;
    __host__ __device__ void init(int M, int N, int G_, int c_) { nM = M / BM; nN = N / BM; nwg = nM * nN; G = G_; c = c_; }
    __host__ __device__ bool next(int i, Unit& u) const {
        const long L = (long)i * G + c; if (L >= nwg) return false;
        int wgid = (int)L; { const int q = nwg / NXCD, r = nwg % NXCD, xcd = wgid % NXCD, off = wgid / NXCD; wgid = (xcd < r ? xcd * (q + 1) : r * (q + 1) + (xcd - r) * q) + off; }
        const int nig = WGM * nN, gid = wgid / nig, fm = gid * WGM, gsz = (nM - fm) < WGM ? (nM - fm) : WGM;
        u.pm = fm + ((wgid % nig) % gsz); u.pn = (wgid % nig) / gsz; return true;
    }
    __device__ __forceinline__ void a_ready(const Unit&) const {}
    __device__ __forceinline__ void done(const Unit&) const {}
};

__device__ __forceinline__ unsigned cvt_pk_bf16(float lo, float hi) { unsigned r; asm volatile("v_cvt_pk_bf16_f32 %0, %1, %2" : "=v"(r) : "v"(lo), "v"(hi)); return r; }
template <class Epi, class Sched, bool ALIGN_EPI = false, bool SP2 = false>
__device__ __forceinline__ void gemm_phase(PG8_LAS unsigned char* lds, const Gemm g, const Sched& S, const Epi& E) {
    int tid = threadIdx.x; asm volatile("" : "+v"(tid)); const int wid = __builtin_amdgcn_readfirstlane(tid >> 6), lane = tid & 63, wr = wid >> 2, wc = wid & 3, fr = lane & 15, fq = lane >> 4;
    const int K = g.K, nt = K / BK;
    unsigned voffA[2], voffB[2];
#pragma unroll
    for (int i = 0; i < 2; ++i) { int R, C; stage_rc(tid * 16 + i * 8192, R, C); const int Rb = Epi::PERM ? ((R & ~31) + perm32(R & 31)) : R;
        voffA[i] = (unsigned)(R * K + C) * 2u; voffB[i] = (unsigned)(Rb * K + C) * 2u; }
    const size_t kstep = (size_t)(BK * 2);
    const size_t hstep = (size_t)HALF * K * 2;
    const size_t tstep = 2 * hstep;
    const unsigned ldsw = (unsigned)wid * 1024u;
    const int aoff = lds_byte(wr * 64 + fr, fq * 8), boff = lds_byte(wc * 32 + fr, fq * 8);
#define PG8_SA(b, h) (((b) * 2 + (h)) * HTB)
#define PG8_SB(b, h) ((4 + (b) * 2 + (h)) * HTB)
#define PG8_STAGE(bufoff, gbase, voff) do { _Pragma("unroll") for (int _i = 0; _i < 2; ++_i) \
        __builtin_amdgcn_global_load_lds((const unsigned*)((const char*)(gbase) + (voff)[_i]), (PG8_LAS unsigned*)(lds + (bufoff) + ldsw + _i * 8192), 16, 0, 0); } while (0)
#define PG8_LDA(dst, b, h) do { _Pragma("unroll") for (int m = 0; m < 4; ++m) _Pragma("unroll") for (int k = 0; k < 2; ++k) dst[m][k] = *(const PG8_LAS bf16x8*)(lds + PG8_SA(b, h) + aoff + m * 2048 + k * 1024); } while (0)
#define PG8_LDB(dst, b, h) do { _Pragma("unroll") for (int n = 0; n < 2; ++n) _Pragma("unroll") for (int k = 0; k < 2; ++k) dst[n][k] = *(const PG8_LAS bf16x8*)(lds + PG8_SB(b, h) + boff + n * 2048 + k * 1024); } while (0)
#define PG8_MMA(ai, bj, At, Bt) do { __builtin_amdgcn_s_setprio(1); _Pragma("unroll") for (int m = 0; m < 4; ++m) _Pragma("unroll") for (int n = 0; n < 2; ++n) _Pragma("unroll") for (int k = 0; k < 2; ++k) \
        acc[ai][bj][m][n] = __builtin_amdgcn_mfma_f32_16x16x32_bf16(Bt[n][k], At[m][k], acc[ai][bj][m][n], 0, 0, 0); __builtin_amdgcn_s_setprio(0); } while (0)
#define PG8_WAIT_V(n) asm volatile("s_waitcnt vmcnt(" #n ")" ::: "memory")
#define PG8_WAIT_L(n) asm volatile("s_waitcnt lgkmcnt(" #n ")" ::: "memory")
#define PG8_BAR __builtin_amdgcn_s_barrier()
#define PG8_SCHED __builtin_amdgcn_sched_barrier(0)
    Unit cur, nxt; int ui = 0;
    if (!S.next(0, cur)) return;
    f32x4 acc[2][2][4][2];
#pragma unroll
    for (int a = 0; a < 2; ++a)
#pragma unroll
        for (int b = 0; b < 2; ++b)
#pragma unroll
            for (int m = 0; m < 4; ++m)
#pragma unroll
                for (int n = 0; n < 2; ++n) acc[a][b][m][n] = (f32x4){0.f, 0.f, 0.f, 0.f};
    bf16x8 At[4][2], B0[2][2], B1[2][2];
    const char* cA = (const char*)g.A + (size_t)cur.pm * tstep; const char* cB = (const char*)g.Bt + (size_t)cur.pn * tstep;
    S.a_ready(cur);
    if constexpr (SP2) {
        PG8_STAGE(PG8_SB(0, 0), cB, voffB); PG8_STAGE(PG8_SB(0, 1), cB + hstep, voffB); PG8_STAGE(PG8_SA(0, 0), cA, voffA); PG8_STAGE(PG8_SA(0, 1), cA + hstep, voffA);
        if (wr == 1) PG8_BAR;
        PG8_WAIT_V(2); PG8_BAR;
        PG8_STAGE(PG8_SB(1, 0), cB + kstep, voffB); PG8_STAGE(PG8_SA(1, 0), cA + kstep, voffA); PG8_STAGE(PG8_SB(1, 1), cB + hstep + kstep, voffB);
        PG8_WAIT_V(6); PG8_BAR;
    } else {
        PG8_STAGE(PG8_SB(0, 0), cB, voffB); PG8_STAGE(PG8_SA(0, 0), cA, voffA); PG8_STAGE(PG8_SB(0, 1), cB + hstep, voffB); PG8_STAGE(PG8_SA(0, 1), cA + hstep, voffA);
        if (wr == 1) PG8_BAR;
        PG8_WAIT_V(4); PG8_BAR;
        PG8_STAGE(PG8_SB(1, 0), cB + kstep, voffB); PG8_STAGE(PG8_SA(1, 0), cA + kstep, voffA); PG8_STAGE(PG8_SB(1, 1), cB + hstep + kstep, voffB);
        PG8_WAIT_V(6); PG8_BAR;
    }
    for (;;) {
        const bool has_next = S.next(ui + 1, nxt);
        const char* nA = has_next ? (const char*)g.A + (size_t)nxt.pm * tstep : cA; const char* nB = has_next ? (const char*)g.Bt + (size_t)nxt.pn * tstep : cB;
        for (int t = 0; t < nt; t += 2) {
            const bool last = (t == nt - 2);
            const char* a1 = cA + (size_t)(t + 1) * kstep;
            const char* a2 = last ? nA : cA + (size_t)(t + 2) * kstep; const char* b2 = last ? nB : cB + (size_t)(t + 2) * kstep;
            const char* a3 = a2 + kstep; const char* b3 = b2 + kstep;
            if (last && has_next) S.a_ready(nxt);
            if constexpr (SP2) {
            PG8_LDB(B0, 0, 0); PG8_LDB(B1, 0, 1); PG8_SCHED; PG8_LDA(At, 0, 0); PG8_STAGE(PG8_SA(1, 1), a1 + hstep, voffA);
            PG8_WAIT_V(8); PG8_WAIT_L(0); PG8_BAR; PG8_MMA(0, 0, At, B0); PG8_MMA(0, 1, At, B1); PG8_BAR; PG8_SCHED;
            PG8_LDA(At, 0, 1); PG8_STAGE(PG8_SB(0, 0), b2, voffB); PG8_STAGE(PG8_SB(0, 1), b2 + hstep, voffB); PG8_STAGE(PG8_SA(0, 0), a2, voffA);
            PG8_WAIT_V(8); PG8_WAIT_L(0); PG8_BAR; PG8_MMA(1, 0, At, B0); PG8_MMA(1, 1, At, B1); PG8_BAR; PG8_SCHED;
            PG8_LDB(B0, 1, 0); PG8_LDB(B1, 1, 1); PG8_SCHED; PG8_LDA(At, 1, 0); PG8_STAGE(PG8_SA(0, 1), a2 + hstep, voffA);
            PG8_WAIT_V(8); PG8_WAIT_L(0); PG8_BAR; PG8_MMA(0, 0, At, B0); PG8_MMA(0, 1, At, B1); PG8_BAR; PG8_SCHED;
            PG8_LDA(At, 1, 1); PG8_STAGE(PG8_SB(1, 0), b3, voffB); PG8_STAGE(PG8_SB(1, 1), b3 + hstep, voffB); PG8_STAGE(PG8_SA(1, 0), a3, voffA);
            PG8_WAIT_V(8); PG8_WAIT_L(0); PG8_BAR; PG8_MMA(1, 0, At, B0); PG8_MMA(1, 1, At, B1); PG8_BAR; PG8_SCHED;
            } else {
            PG8_LDB(B0, 0, 0); PG8_SCHED; PG8_LDA(At, 0, 0); PG8_STAGE(PG8_SA(1, 1), a1 + hstep, voffA);
            PG8_WAIT_L(8); PG8_BAR; PG8_WAIT_L(0); PG8_MMA(0, 0, At, B0); PG8_BAR; PG8_SCHED;
            PG8_LDB(B1, 0, 1); PG8_STAGE(PG8_SB(0, 0), b2, voffB);
            PG8_BAR; PG8_WAIT_L(0); PG8_MMA(0, 1, At, B1); PG8_BAR;
            PG8_LDA(At, 0, 1); PG8_STAGE(PG8_SA(0, 0), a2, voffA);
            PG8_BAR; PG8_WAIT_L(0); PG8_MMA(1, 0, At, B0); PG8_BAR; PG8_SCHED;
            PG8_STAGE(PG8_SB(0, 1), b2 + hstep, voffB);
            PG8_WAIT_V(6); PG8_BAR; PG8_MMA(1, 1, At, B1); PG8_BAR;
            PG8_LDB(B0, 1, 0); PG8_SCHED; PG8_LDA(At, 1, 0); PG8_STAGE(PG8_SA(0, 1), a2 + hstep, voffA);
            PG8_WAIT_L(8); PG8_BAR; PG8_WAIT_L(0); PG8_MMA(0, 0, At, B0); PG8_BAR; PG8_SCHED;
            PG8_LDB(B1, 1, 1); PG8_STAGE(PG8_SB(1, 0), b3, voffB);
            PG8_BAR; PG8_WAIT_L(0); PG8_MMA(0, 1, At, B1); PG8_BAR;
            PG8_LDA(At, 1, 1); PG8_STAGE(PG8_SA(1, 0), a3, voffA);
            PG8_BAR; PG8_WAIT_L(0); PG8_MMA(1, 0, At, B0); PG8_BAR; PG8_SCHED;
            PG8_STAGE(PG8_SB(1, 1), b3 + hstep, voffB);
            PG8_WAIT_V(6); PG8_BAR; PG8_MMA(1, 1, At, B1); PG8_BAR;
            }
        }
        if constexpr (ALIGN_EPI) { if (wr == 0) PG8_BAR; }
        if constexpr (!Epi::AFTER_DRAIN) { E(acc, cur, wr, wc, fr, fq); S.done(cur); }
        if (!has_next) break;
#pragma unroll
        for (int a = 0; a < 2; ++a)
#pragma unroll
            for (int b = 0; b < 2; ++b)
#pragma unroll
                for (int m = 0; m < 4; ++m)
#pragma unroll
                    for (int n = 0; n < 2; ++n) acc[a][b][m][n] = (f32x4){0.f, 0.f, 0.f, 0.f};
        cur = nxt; cA = nA; cB = nB; ++ui;
        if constexpr (ALIGN_EPI) { if (wr == 1) PG8_BAR; }
    }
    PG8_WAIT_V(0);
    if constexpr (!ALIGN_EPI) { if (wr == 0) PG8_BAR; }
    PG8_BAR;
    if constexpr (Epi::AFTER_DRAIN) { E.fused(acc, cur, wr, wc, fr, fq, lds, wid, lane); S.done(cur); }
#undef PG8_SA
#undef PG8_SB
#undef PG8_STAGE
#undef PG8_LDA
#undef PG8_LDB
#undef PG8_MMA
#undef PG8_WAIT_V
#undef PG8_WAIT_L
#undef PG8_BAR
#undef PG8_SCHED
}
}

#define DI __device__ __forceinline__
#define LAS __attribute__((address_space(3)))
typedef LAS unsigned char* lptr;
typedef unsigned short bf16_t;
typedef short bf16x8 __attribute__((ext_vector_type(8)));
typedef short s16x4 __attribute__((ext_vector_type(4)));
typedef float f32x4 __attribute__((ext_vector_type(4)));
typedef float f32x16 __attribute__((ext_vector_type(16)));
typedef unsigned u32x4 __attribute__((ext_vector_type(4)));
typedef unsigned u32x2 __attribute__((ext_vector_type(2)));
typedef float f32x2_t __attribute__((ext_vector_type(2)));
typedef __bf16 bf16x2_t __attribute__((ext_vector_type(2)));
using pg8::Unit;

constexpr int MTOK = 32768, SEQ = 4096, DM = 1024;
constexpr int EVEN_IN = 3592, ODD_IN = 4104;
constexpr int PE = 3584;
constexpr int PO = 4096;
constexpr float EPS = 1e-6f;
constexpr float LOG2E = 1.4426950408889634f;
constexpr float NEGBIG = -1e30f;
constexpr size_t MiB = 1u << 20;
constexpr size_t WS_CTL = 0, WS_GATE = 1 * MiB, WS_CUM = 2 * MiB, WS_GL = 3 * MiB, WS_COS = 4 * MiB, WS_SIN = 8 * MiB, WS_PB = 12 * MiB;
constexpr size_t WS_W = 28 * MiB, WS_O = 60 * MiB, WS_P = 124 * MiB, WS_H = 380 * MiB, WS_END = 512 * MiB;
constexpr size_t WS_SS = WS_GL + 512 * 1024;
constexpr size_t WS_REC = WS_H;
constexpr size_t WS_QK = WS_P + 224 * MiB;
constexpr size_t W_IN = 0, W_OUT = 8 * MiB, W_UP = 10 * MiB, W_DOWN = 18 * MiB, W_PLE = 26 * MiB, W_GATE = 27 * MiB;
constexpr int LDS_BYTES = 147456;
constexpr int LDS_UNIT_WORD = 147392;

struct Params { const float* in[24]; float* out; unsigned char* ws; };

DI unsigned pk2(float lo, float hi) { f32x2_t v = {lo, hi}; bf16x2_t b = __builtin_convertvector(v, bf16x2_t); return __builtin_bit_cast(unsigned, b); }
DI float bflo(unsigned w) { return __uint_as_float(w << 16); }
DI float bfhi(unsigned w) { return __uint_as_float(w & 0xffff0000u); }
DI float bf2f(unsigned short b) { return __uint_as_float(((unsigned)b) << 16); }
DI int crow(int i, int h) { return (i & 3) + 8 * (i >> 2) + 4 * h; }
DI int krow(int s, int h, int j) { return 16 * s + 8 * (j >> 2) + 4 * h + (j & 3); }
template <class T> DI T lld(lptr p, int off) { return *(const LAS T*)(p + off); }
template <class T> DI void lst(lptr p, int off, T v) { *(LAS T*)(p + off) = v; }
DI f32x16 mfma32(bf16x8 a, bf16x8 b, f32x16 c) { return __builtin_amdgcn_mfma_f32_32x32x16_bf16(a, b, c, 0, 0, 0); }
DI bf16x8 pack8(const f32x16& x, int s) {
    u32x4 p; p.x = pk2(x[8 * s], x[8 * s + 1]); p.y = pk2(x[8 * s + 2], x[8 * s + 3]); p.z = pk2(x[8 * s + 4], x[8 * s + 5]); p.w = pk2(x[8 * s + 6], x[8 * s + 7]);
    return __builtin_bit_cast(bf16x8, p);
}
DI s16x4 vtr(lptr p) { return __builtin_bit_cast(s16x4, __builtin_amdgcn_ds_read_tr16_b64_v4i16((LAS s16x4*)p)); }
DI int tid_() { int t = threadIdx.x; asm volatile("" : "+v"(t)); return t; }
DI float shx(float v, int m) { const int lane = tid_() & 63; return __builtin_bit_cast(float, __builtin_amdgcn_ds_bpermute((lane ^ m) << 2, __builtin_bit_cast(int, v))); }
DI float wave_sum(float v) { v += shx(v, 32); v += shx(v, 16); v += shx(v, 8); v += shx(v, 4); v += shx(v, 2); v += shx(v, 1); return v; }
DI float sigmoidf_(float x) { return 1.f / (1.f + __expf(-x)); }
DI float softplusf_(float x) { return fmaxf(x, 0.f) + log1pf(__expf(-fabsf(x))); }
DI int bid_() { return (int)blockIdx.x; }
DI f32x16 zero16() { f32x16 z; for (int i = 0; i < 16; ++i) z[i] = 0.f; return z; }

template <class F> DI void epi_iter(const f32x4 (&acc)[2][2][4][2], const Unit& u, int wr, int wc, int fr, int fq, F f) {
    const int row0 = u.pm * 256 + wr * 64 + fr, col0 = u.pn * 256 + wc * 32 + 8 * fq;
#pragma unroll
    for (int ai = 0; ai < 2; ++ai)
#pragma unroll
        for (int m = 0; m < 4; ++m)
#pragma unroll
            for (int bj = 0; bj < 2; ++bj) { f(row0 + ai * 128 + m * 16, col0 + bj * 128, acc[ai][bj][m][0], acc[ai][bj][m][1]); if ((m == 3) && bj) asm volatile("" ::: "memory"); }
}
template <int MODE  > struct EpiStore {
    static constexpr bool PERM = true, AFTER_DRAIN = false;
    bf16_t* O; int ldc; const float* SS;
    DI void operator()(const f32x4 (&acc)[2][2][4][2], const Unit& u, int wr, int wc, int fr, int fq) const {
        bf16_t* Op = O; const int ld = ldc; const float* ssp = SS;
        epi_iter(acc, u, wr, wc, fr, fq, [&](int row, int col, f32x4 v0, f32x4 v1) {
            if (MODE == 1) { const float rs = rsqrtf(ssp[row] * (1.f / 1024.f) + EPS); for (int e = 0; e < 4; ++e) { float a = fmaxf(v0[e], 0.f) * rs; v0[e] = a * a; float b = fmaxf(v1[e], 0.f) * rs; v1[e] = b * b; } }
            if (MODE == 2) { for (int e = 0; e < 4; ++e) { v0[e] = sigmoidf_(v0[e]); v1[e] = sigmoidf_(v1[e]); } }
            u32x4 w; w.x = pk2(v0[0], v0[1]); w.y = pk2(v0[2], v0[3]); w.z = pk2(v1[0], v1[1]); w.w = pk2(v1[2], v1[3]);
            *(u32x4*)(Op + (size_t)row * ld + col) = w;
        });
    }
};
struct EpiInProj {
    static constexpr bool PERM = true, AFTER_DRAIN = false;
    bf16_t* O; int ldc; int rlo, rhi; const float* rc; const float* rsn;
    DI void operator()(const f32x4 (&acc)[2][2][4][2], const Unit& u, int wr, int wc, int fr, int fq) const {
        bf16_t* Op = O; const int ld = ldc, lo = rlo, hi = rhi; const float* cp = rc; const float* sp = rsn;
        epi_iter(acc, u, wr, wc, fr, fq, [&](int row, int col, f32x4 v0, f32x4 v1) {
            if (col >= lo && col < hi) {
                const int i0 = ((col - lo) & 63) >> 1;
                const f32x4 c4 = *(const f32x4*)(cp + (size_t)row * 32 + i0), s4 = *(const f32x4*)(sp + (size_t)row * 32 + i0);
                const float sc = (col - lo) < 512 ? 0.125f * LOG2E : 1.f;
                for (int e = 0; e < 4; ++e) { const float y1 = (v0[e] * c4[e] - v1[e] * s4[e]) * sc, y2 = (v1[e] * c4[e] + v0[e] * s4[e]) * sc; v0[e] = y1; v1[e] = y2; }
            }
            u32x4 w; w.x = pk2(v0[0], v0[1]); w.y = pk2(v0[2], v0[3]); w.z = pk2(v1[0], v1[1]); w.w = pk2(v1[2], v1[3]);
            *(u32x4*)(Op + (size_t)row * ld + col) = w;
        });
    }
};
struct EpiResid {
    static constexpr bool PERM = true, AFTER_DRAIN = false;
    const float* Xi; float* Xo; bf16_t* Hb; float* SS;
    DI void operator()(const f32x4 (&acc)[2][2][4][2], const Unit& u, int wr, int wc, int fr, int fq) const {
        const float* xi = Xi; float* xo = Xo; bf16_t* hb = Hb; float* ssp = SS;
        const int row0 = u.pm * 256 + wr * 64 + fr, col0 = u.pn * 256 + wc * 32 + 8 * fq;
#pragma unroll
        for (int ai = 0; ai < 2; ++ai)
#pragma unroll
            for (int m = 0; m < 4; ++m) { const int row = row0 + ai * 128 + m * 16; float ss = 0.f;
#pragma unroll
                for (int bj = 0; bj < 2; ++bj) { const size_t o = (size_t)row * DM + col0 + bj * 128;
                    f32x4 a = *(const f32x4*)(xi + o), b = *(const f32x4*)(xi + o + 4);
                    a += acc[ai][bj][m][0]; b += acc[ai][bj][m][1];
                    *(f32x4*)(xo + o) = a; *(f32x4*)(xo + o + 4) = b;
                    if (hb) { u32x4 w; w.x = pk2(a[0], a[1]); w.y = pk2(a[2], a[3]); w.z = pk2(b[0], b[1]); w.w = pk2(b[2], b[3]); *(u32x4*)(hb + o) = w; }
                    ss += a[0] * a[0] + a[1] * a[1] + a[2] * a[2] + a[3] * a[3] + b[0] * b[0] + b[1] * b[1] + b[2] * b[2] + b[3] * b[3]; }
                if (ssp) { ss += shx(ss, 16); ss += shx(ss, 32); if (fq == 0) atomicAdd(ssp + row, ss); }
                if (m == 3) asm volatile("" ::: "memory"); }
    }
};
struct EpiPle {
    static constexpr bool PERM = true, AFTER_DRAIN = false;
    float* X; const bf16_t* G;
    DI void operator()(const f32x4 (&acc)[2][2][4][2], const Unit& u, int wr, int wc, int fr, int fq) const {
        float* x = X; const bf16_t* g = G;
        epi_iter(acc, u, wr, wc, fr, fq, [&](int row, int col, f32x4 v0, f32x4 v1) {
            const size_t o = (size_t)row * DM + col;
            f32x4 a = *(const f32x4*)(x + o), b = *(const f32x4*)(x + o + 4);
            const u32x4 gw = *(const u32x4*)(g + o);
            a[0] += v0[0] * bflo(gw.x); a[1] += v0[1] * bfhi(gw.x); a[2] += v0[2] * bflo(gw.y); a[3] += v0[3] * bfhi(gw.y);
            b[0] += v1[0] * bflo(gw.z); b[1] += v1[1] * bfhi(gw.z); b[2] += v1[2] * bflo(gw.w); b[3] += v1[3] * bfhi(gw.w);
            *(f32x4*)(x + o) = a; *(f32x4*)(x + o + 4) = b;
        });
    }
};
template <class Epi> DI void run_gemm(lptr lds, const bf16_t* A, const bf16_t* Bt, int N, int K, const Epi& E) {
    asm volatile("" : "+s"(N), "+s"(K));
    pg8::Gemm g{A, Bt, MTOK, N, K}; pg8::StaticOrder S; S.init(MTOK, N, (int)gridDim.x, (int)bid_());
    pg8::gemm_phase<Epi, pg8::StaticOrder, true, true>(lds, g, S, E);
}

struct RevOrder : pg8::StaticOrder {
    DI bool next(int i, Unit& u) const {
        const long Lf = (long)i * G + c; if (Lf >= nwg) return false;
        int wgid = nwg - 1 - (int)Lf; { const int q = nwg / pg8::NXCD, r = nwg % pg8::NXCD, xcd = wgid % pg8::NXCD, off = wgid / pg8::NXCD; wgid = (xcd < r ? xcd * (q + 1) : r * (q + 1) + (xcd - r) * q) + off; }
        const int nig = pg8::WGM * nN, gid = wgid / nig, fm = gid * pg8::WGM, gsz = (nM - fm) < pg8::WGM ? (nM - fm) : pg8::WGM;
        u.pm = fm + ((wgid % nig) % gsz); u.pn = (wgid % nig) / gsz; return true;
    }
};
template <class Epi> DI void run_gemm_rev(lptr lds, const bf16_t* A, const bf16_t* Bt, int N, int K, const Epi& E) {
    asm volatile("" : "+s"(N), "+s"(K));
    pg8::Gemm g{A, Bt, MTOK, N, K}; RevOrder S; S.init(MTOK, N, (int)gridDim.x, (int)bid_());
    pg8::gemm_phase<Epi, RevOrder, true, true>(lds, g, S, E);
}

DI void phase_prologue(const Params& p) {
    const int gtid = bid_() * 512 + tid_(), stride = gridDim.x * 512;
    const int* pos = (const int*)p.in[2];
    float* rc = (float*)(p.ws + WS_COS); float* rs = (float*)(p.ws + WS_SIN);
    for (int i = gtid; i < MTOK * 32; i += stride) {
        const int tok = i >> 5, f = i & 31;
        const float inv = exp2f(-(float)(2 * f) * (1.f / 64.f) * 13.287712379549449f);
        const float ang = (float)pos[tok] * inv;
        const float C1 = 0.15915494309189535f;
        const float rh = ang * C1; const float rl = fmaf(ang, C1, -rh);
        float fr = rh - rintf(rh); fr += rl;
        rc[i] = __builtin_amdgcn_cosf(fr); rs[i] = __builtin_amdgcn_sinf(fr);
    }
}

struct ConvJob { const float* W; bf16_t* Wt; const float* rs; int K, ldn, Nout, split; int rlo, rhi; };
DI void conv_tile(const ConvJob& J, int t, lptr lds) {
    const int tid = tid_(); const int nkt = J.K / 64;
    const int kt = t % nkt, nt = t / nkt; const int k0 = kt * 64, n0d = nt * 256, n0s = n0d + (n0d >= J.split ? 8 : 0);
#pragma unroll
    for (int it = 0; it < 8; ++it) { const int kr = it * 8 + (tid >> 6), nc = (tid & 63) * 4;
        int scol = n0s + nc;
        if (n0d >= J.rlo && n0d < J.rhi) { const int d = n0d + nc - J.rlo, jj = d & 63, chunk = jj >> 3; scol = J.rlo + (n0s - n0d) + (d & ~63) + ((jj & 4) ? 32 + 4 * chunk : 4 * chunk); }
        const f32x4 v = *(const f32x4*)(J.W + (size_t)(k0 + kr) * J.ldn + scol);
        const float rsc = J.rs ? J.rs[k0 + kr] : 1.f;
        lst<f32x4>(lds, (kr * 260 + nc) * 4, v * rsc); }
    __syncthreads();
    { const int n = tid >> 1, kh = (tid & 1) * 32;
#pragma unroll
        for (int q = 0; q < 4; ++q) { float v[8];
            for (int e = 0; e < 8; ++e) v[e] = lld<float>(lds, ((kh + 8 * q + e) * 260 + n) * 4);
            u32x4 w; w.x = pk2(v[0], v[1]); w.y = pk2(v[2], v[3]); w.z = pk2(v[4], v[5]); w.w = pk2(v[6], v[7]);
            *(u32x4*)(J.Wt + (size_t)(n0d + n) * J.K + k0 + kh + 8 * q) = w; } }
    __syncthreads();
}

DI void phase_norm(const float* X, const float* nw, bf16_t* H, const float* Wg, int ldw, int col0, float* GATE, lptr lds) {
    const int tid = tid_(), wave = tid >> 6, lane = tid & 63;
    if (Wg) { for (int i = tid; i < 1024 * 8; i += 512) lst<float>(lds, 32768 + ((i & 7) * 1024 + (i >> 3)) * 4, Wg[(size_t)(i >> 3) * ldw + col0 + (i & 7)]); }
    __syncthreads();
    f32x4 wv[4];
#pragma unroll
    for (int k = 0; k < 4; ++k) wv[k] = *(const f32x4*)(nw + 4 * lane + 256 * k);
    for (int row = bid_() * 8 + wave; row < MTOK; row += gridDim.x * 8) {
        f32x4 x[4]; float ss = 0.f;
#pragma unroll
        for (int k = 0; k < 4; ++k) { x[k] = *(const f32x4*)(X + (size_t)row * DM + 4 * lane + 256 * k); ss += x[k][0] * x[k][0] + x[k][1] * x[k][1] + x[k][2] * x[k][2] + x[k][3] * x[k][3]; }
        ss = wave_sum(ss);
        const float rstd = rsqrtf(ss * (1.f / 1024.f) + EPS);
#pragma unroll
        for (int k = 0; k < 4; ++k) { for (int e = 0; e < 4; ++e) x[k][e] = x[k][e] * rstd * wv[k][e];
            u32x2 w; w.x = pk2(x[k][0], x[k][1]); w.y = pk2(x[k][2], x[k][3]); *(u32x2*)(H + (size_t)row * DM + 4 * lane + 256 * k) = w; }
        if (Wg) {
            float g[8]; for (int e = 0; e < 8; ++e) g[e] = 0.f;
#pragma unroll
            for (int k = 0; k < 4; ++k)
#pragma unroll
                for (int q = 0; q < 8; ++q) { const f32x4 w4 = lld<f32x4>(lds, 32768 + (q * 1024 + 4 * lane + 256 * k) * 4);
                    g[q] += x[k][0] * w4[0] + x[k][1] * w4[1] + x[k][2] * w4[2] + x[k][3] * w4[3]; }
            for (int e = 0; e < 8; ++e) g[e] = wave_sum(g[e]);
            if (lane == 0) { *(f32x4*)(GATE + (size_t)row * 8) = (f32x4){g[0], g[1], g[2], g[3]}; *(f32x4*)(GATE + (size_t)row * 8 + 4) = (f32x4){g[4], g[5], g[6], g[7]}; }
        }
    }
    __syncthreads();
}
DI void phase_final_norm(float* X, const float* nw) {
    const int tid = tid_(), wave = tid >> 6, lane = tid & 63;
    f32x4 wv[4];
#pragma unroll
    for (int k = 0; k < 4; ++k) wv[k] = *(const f32x4*)(nw + 4 * lane + 256 * k);
    for (int row = bid_() * 8 + wave; row < MTOK; row += gridDim.x * 8) {
        f32x4 x[4]; float ss = 0.f;
#pragma unroll
        for (int k = 0; k < 4; ++k) { x[k] = *(const f32x4*)(X + (size_t)row * DM + 4 * lane + 256 * k); ss += x[k][0] * x[k][0] + x[k][1] * x[k][1] + x[k][2] * x[k][2] + x[k][3] * x[k][3]; }
        ss = wave_sum(ss);
        const float rstd = rsqrtf(ss * (1.f / 1024.f) + EPS);
#pragma unroll
        for (int k = 0; k < 4; ++k) { for (int e = 0; e < 4; ++e) x[k][e] = x[k][e] * rstd * wv[k][e]; *(f32x4*)(X + (size_t)row * DM + 4 * lane + 256 * k) = x[k]; }
    }
}

DI void phase_rope(const Params& p) {
    bf16_t* P = (bf16_t*)(p.ws + WS_P); const float* rc = (const float*)(p.ws + WS_COS); const float* rs = (const float*)(p.ws + WS_SIN);
    const int tid = tid_(), wave = tid >> 6, lane = tid & 63;
    const int gidx = lane >> 2, sub = lane & 3;
    const int col = 2048 + (gidx >= 8 ? 512 : 0) + (gidx & 7) * 64 + sub * 8;
    const float sc = gidx >= 8 ? 1.f : 0.125f * LOG2E;
    for (int row = bid_() * 8 + wave; row < MTOK; row += gridDim.x * 8) {
        bf16_t* pr = P + (size_t)row * PE + col;
        const u32x4 a = *(const u32x4*)pr, b = *(const u32x4*)(pr + 32);
        const f32x4 c0 = *(const f32x4*)(rc + row * 32 + sub * 8), c1 = *(const f32x4*)(rc + row * 32 + sub * 8 + 4);
        const f32x4 s0 = *(const f32x4*)(rs + row * 32 + sub * 8), s1 = *(const f32x4*)(rs + row * 32 + sub * 8 + 4);
        float x1[8] = {bflo(a.x), bfhi(a.x), bflo(a.y), bfhi(a.y), bflo(a.z), bfhi(a.z), bflo(a.w), bfhi(a.w)};
        float x2[8] = {bflo(b.x), bfhi(b.x), bflo(b.y), bfhi(b.y), bflo(b.z), bfhi(b.z), bflo(b.w), bfhi(b.w)};
        float cc[8] = {c0[0], c0[1], c0[2], c0[3], c1[0], c1[1], c1[2], c1[3]}, sn[8] = {s0[0], s0[1], s0[2], s0[3], s1[0], s1[1], s1[2], s1[3]};
        float y1[8], y2[8];
        for (int e = 0; e < 8; ++e) { y1[e] = (x1[e] * cc[e] - x2[e] * sn[e]) * sc; y2[e] = (x2[e] * cc[e] + x1[e] * sn[e]) * sc; }
        u32x4 oa, ob; oa.x = pk2(y1[0], y1[1]); oa.y = pk2(y1[2], y1[3]); oa.z = pk2(y1[4], y1[5]); oa.w = pk2(y1[6], y1[7]);
        ob.x = pk2(y2[0], y2[1]); ob.y = pk2(y2[2], y2[3]); ob.z = pk2(y2[4], y2[5]); ob.w = pk2(y2[6], y2[7]);
        *(u32x4*)pr = oa; *(u32x4*)(pr + 32) = ob;
    }
}

DI void phase_cumsum(const Params& p, int j, lptr lds) {
    const float* GATE = (const float*)(p.ws + WS_GATE); float* CUM = (float*)(p.ws + WS_CUM); const float* bfg = p.in[18] + j * 8;
    const int tid = tid_();
    for (int s = bid_(); s < 64; s += gridDim.x) {
        const int b = s >> 3, h = s & 7; const float bias = bfg[h];
        float v[8]; float run = 0.f;
        for (int e = 0; e < 8; ++e) { const float f = GATE[((size_t)b * SEQ + tid * 8 + e) * 8 + h] + bias; run += -softplusf_(-f); v[e] = run; }
        float inc = run; const int lane = tid & 63, wv = tid >> 6;
        for (int d = 1; d < 64; d <<= 1) { const float t = __builtin_bit_cast(float, __builtin_amdgcn_ds_bpermute(((lane - d) & 63) << 2, __builtin_bit_cast(int, inc))); if (lane >= d) inc += t; }
        __syncthreads();
        if (lane == 63) lst<float>(lds, wv * 4, inc);
        __syncthreads();
        float off = inc - run;
        for (int q = 0; q < 8; ++q) { const float t = lld<float>(lds, q * 4); if (q < wv) off += t; }
        for (int e = 0; e < 8; ++e) CUM[(size_t)s * SEQ + tid * 8 + e] = off + v[e];
    }
    __syncthreads();
}

template <int DQK, bool FOX>
DI void attn_unit(const bf16_t* P, int pitch, int b, int qb, int qcol, int kcol, int vcol, bf16_t* Out, int opitch, int ocol, int gcol, const float* cum, lptr lds) {
    constexpr int KROWB = DQK * 2, KBUF = 64 * KROWB, VBUF = 64 * 256;
    constexpr int REG = KBUF + VBUF, OFF_K = 0, OFF_V = KBUF, OFF_C = 2 * REG;
    constexpr int NKS = DQK / 16;
    constexpr int NKD = KBUF / 8192;
    constexpr float QC = 0.08838834764831845f * LOG2E;
    const int tid = tid_(), w = __builtin_amdgcn_readfirstlane(tid >> 6), lane = tid & 63, r = lane & 31, h = lane >> 5;
    const size_t tokbase = (size_t)b * SEQ;
    const int q0 = qb * 256 + w * 32;
    bf16x8 qf[NKS];
#pragma unroll
    for (int ks = 0; ks < NKS; ++ks) {
        u32x4 qw = *(const u32x4*)(P + (tokbase + q0 + r) * pitch + qcol + 16 * ks + 8 * h);
        if (FOX) { qw.x = pk2(bflo(qw.x) * QC, bfhi(qw.x) * QC); qw.y = pk2(bflo(qw.y) * QC, bfhi(qw.y) * QC); qw.z = pk2(bflo(qw.z) * QC, bfhi(qw.z) * QC); qw.w = pk2(bflo(qw.w) * QC, bfhi(qw.w) * QC); }
        qf[ks] = __builtin_bit_cast(bf16x8, qw);
    }
    const int ntiles = 4 * (qb + 1);
    f32x16 O[4]; for (int d = 0; d < 4; ++d) O[d] = zero16();
    float m_run = NEGBIG, l_run = 0.f;
    float creg = 0.f;
    size_t kgo[NKD], vgo[2];
#pragma unroll
    for (int i = 0; i < NKD; ++i) {
        int row, c;
        if (DQK == 128) { row = 4 * (2 * w + i) + (lane >> 4); c = (lane & 15) ^ (row & 15); }
        else            { row = 8 * w + (lane >> 3);           c = (lane & 7) ^ ((row >> 1) & 7); }
        kgo[i] = (tokbase + row) * pitch + kcol + c * 8;
    }
#pragma unroll
    for (int i = 0; i < 2; ++i) { const int row = 4 * (2 * w + i) + (lane >> 4), c = (lane & 15) ^ (4 * (row & 3)); vgo[i] = (tokbase + row) * pitch + vcol + c * 8; }
    int kx[NKS], vx[4];
#pragma unroll
    for (int ks = 0; ks < NKS; ++ks) kx[ks] = (DQK == 128) ? (r * 256 + (((2 * ks + h) ^ (r & 15)) << 4)) : (r * 128 + (((2 * ks + h) ^ ((r >> 1) & 7)) << 4));
    { const int q4 = (lane & 15) >> 2, p4 = lane & 3, g1 = (lane >> 4) & 1;
#pragma unroll
      for (int d = 0; d < 4; ++d) vx[d] = (4 * h + q4) * 256 + ((4 * (d ^ q4) + 2 * g1 + (p4 >> 1)) << 4) + ((p4 & 1) << 3); }
    const int cfo = 16 * h;
    auto dma = [&](int kt, auto BUFC) {
        constexpr int buf = decltype(BUFC)::value;
        const size_t step = (size_t)kt * 64 * pitch;
#pragma unroll
        for (int i = 0; i < NKD; ++i) __builtin_amdgcn_global_load_lds((const unsigned*)(P + kgo[i] + step), (LAS unsigned*)(lds + OFF_K + buf * REG + (NKD * w + i) * 1024), 16, 0, 0);
#pragma unroll
        for (int i = 0; i < 2; ++i) __builtin_amdgcn_global_load_lds((const unsigned*)(P + vgo[i] + step), (LAS unsigned*)(lds + OFF_V + buf * REG + (2 * w + i) * 1024), 16, 0, 0);
    };
    auto body = [&](int it, auto BUFC) {
        constexpr int buf = decltype(BUFC)::value;
        const int kt = ntiles - 1 - it;
        const bool more = (kt > 0);
        if (more) { dma(kt - 1, std::integral_constant<int, 1 - buf>{}); if (FOX) { if (tid < 64) creg = -cum[(kt - 1) * 64 + tid] * LOG2E; } }
        if (64 * kt <= q0 + 31) {
            f32x16 pp[2];
#pragma unroll
            for (int t2 = 0; t2 < 2; ++t2) {
                if (FOX) {
#pragma unroll
                    for (int g = 0; g < 4; ++g) { const f32x4 ck = lld<f32x4>(lds, OFF_C + buf * 256 + cfo + (32 * t2 + 8 * g) * 4);
                        pp[t2][4 * g] = ck[0]; pp[t2][4 * g + 1] = ck[1]; pp[t2][4 * g + 2] = ck[2]; pp[t2][4 * g + 3] = ck[3]; }
                } else pp[t2] = zero16();
#pragma unroll
                for (int ks = 0; ks < NKS; ++ks) { const bf16x8 kf = lld<bf16x8>(lds + (OFF_K + buf * REG + 32 * t2 * KROWB), kx[ks]); pp[t2] = mfma32(kf, qf[ks], pp[t2]); } }
            const bool diag = (64 * kt + 63 > q0);
            if (diag) {
#pragma unroll
                for (int t2 = 0; t2 < 2; ++t2)
#pragma unroll
                    for (int i = 0; i < 16; ++i) { const int key = 64 * kt + 32 * t2 + crow(i, h); if (key > q0 + r) pp[t2][i] = NEGBIG; }
            }
            float mx = NEGBIG;
#pragma unroll
            for (int t2 = 0; t2 < 2; ++t2)
#pragma unroll
                for (int i = 0; i < 16; ++i) mx = fmaxf(mx, pp[t2][i]);
            mx = fmaxf(mx, shx(mx, 32));
            const float m_new = fmaxf(m_run, mx);
            const float alpha = __builtin_amdgcn_exp2f(m_run - m_new);
            const bool changed = __builtin_amdgcn_ballot_w64(m_new > m_run) != 0ull;
            m_run = m_new;
            float ls = 0.f;
#pragma unroll
            for (int t2 = 0; t2 < 2; ++t2)
#pragma unroll
                for (int i = 0; i < 16; ++i) { const float e = __builtin_amdgcn_exp2f(pp[t2][i] - m_new); pp[t2][i] = e; ls += e; }
            l_run = l_run * alpha + ls;
            if (changed) {
#pragma unroll
                for (int d = 0; d < 4; ++d) O[d] *= alpha;
            }
            bf16x8 pf[4];
#pragma unroll
            for (int s = 0; s < 4; ++s) pf[s] = pack8(pp[s >> 1], s & 1);
#pragma unroll
            for (int d = 0; d < 4; ++d)
#pragma unroll
                for (int s = 0; s < 4; ++s) {
                    const s16x4 lo = vtr(lds + (OFF_V + buf * REG + (16 * s) * 256) + vx[d]), hi = vtr(lds + (OFF_V + buf * REG + (16 * s + 8) * 256) + vx[d]);
                    const bf16x8 vf = __builtin_shufflevector(lo, hi, 0, 1, 2, 3, 4, 5, 6, 7);
                    O[d] = mfma32(vf, pf[s], O[d]);
                }
        }
        if (FOX) { if (more && tid < 64) lst<float>(lds, OFF_C + (1 - buf) * 256 + tid * 4, creg); }
        asm volatile("s_waitcnt vmcnt(0)" ::: "memory");
        __syncthreads();
    };
    dma(ntiles - 1, std::integral_constant<int, 0>{});
    if (FOX) { if (tid < 64) lst<float>(lds, OFF_C + tid * 4, -cum[(ntiles - 1) * 64 + tid] * LOG2E); }
    asm volatile("s_waitcnt vmcnt(0)" ::: "memory");
    __syncthreads();
#pragma unroll 1
    for (int kt = 0; kt < ntiles; kt += 2) { body(kt, std::integral_constant<int, 0>{}); body(kt + 1, std::integral_constant<int, 1>{}); }
    const float l = l_run + shx(l_run, 32);
    const float inv = 1.f / l;
    const size_t tok = tokbase + q0 + r;
#pragma unroll
    for (int d = 0; d < 4; ++d)
#pragma unroll
        for (int g = 0; g < 4; ++g) {
            const int dv = 32 * d + 8 * g + 4 * h;
            float v[4]; for (int e = 0; e < 4; ++e) v[e] = O[d][4 * g + e] * inv;
            if (FOX) { const u32x2 gw = *(const u32x2*)(P + tok * pitch + gcol + dv);
                v[0] *= sigmoidf_(bflo(gw.x)); v[1] *= sigmoidf_(bfhi(gw.x)); v[2] *= sigmoidf_(bflo(gw.y)); v[3] *= sigmoidf_(bfhi(gw.y)); }
            u32x2 o; o.x = pk2(v[0], v[1]); o.y = pk2(v[2], v[3]);
            *(u32x2*)(Out + tok * opitch + ocol + dv) = o;
        }
}

template <int C, int END, class F> DI void for_const(F& f) { if constexpr (C < END) { f(std::integral_constant<int, C>{}); for_const<C + 1, END>(f); } }
constexpr int T1_Q = 0, T1_K = 17408, T1_V = 34816, T1_L = 52224, T1_GC = 69632, T1_BETA = T1_GC + 256, T1_EGC = T1_GC + 512, T1_STRIDE = 70656;
constexpr float QSCALE = 0.08838834764831845f;
DI void g1_team(const Params& p, int j, int unit, lptr lds) {
    const bf16_t* P = (const bf16_t*)(p.ws + WS_P);
    const float* GATE = (const float*)(p.ws + WS_GATE);
    const float* cw = p.in[7] + (size_t)j * 4 * 1536;
    const int b = unit >> 8, h = (unit >> 6) & 3, n = unit & 63;
    const int tid = tid_(), lt = tid & 255, lw = __builtin_amdgcn_readfirstlane((tid >> 6) & 3), lane = tid & 63, r = lane & 31, hh = lane >> 5;
    unsigned char* rec = p.ws + WS_REC + (size_t)unit * 65536;
    unsigned char* qkrec = p.ws + WS_QK + (size_t)unit * 8192;
    if (lt < 64) {
        const size_t tok = (size_t)b * SEQ + 64 * n + lt;
        const float bb = GATE[tok * 8 + h], aa = GATE[tok * 8 + 4 + h];
        const float beta = sigmoidf_(bb);
        float g = -__expf(p.in[8][j * 4 + h]) * softplusf_(aa + p.in[9][j * 4 + h]);
        for (int d = 1; d < 64; d <<= 1) { const float t = __builtin_bit_cast(float, __builtin_amdgcn_ds_bpermute(((lane - d) & 63) << 2, __builtin_bit_cast(int, g))); if (lane >= d) g += t; }
        lst<float>(lds, T1_GC + lt * 4, g); lst<float>(lds, T1_BETA + lt * 4, beta); lst<float>(lds, T1_EGC + lt * 4, __expf(g));
    }
    if (lw < 3) {
        const int rb = lt / 48, cg = lt % 48, part = cg >> 4, sub = cg & 15;
        const int col = part * 512 + h * 128 + sub * 8, t0 = 64 * n + rb * 16;
        f32x4 wl[4][2];
#pragma unroll
        for (int i = 0; i < 4; ++i) { wl[i][0] = *(const f32x4*)(cw + i * 1536 + col); wl[i][1] = *(const f32x4*)(cw + i * 1536 + col + 4); }
        u32x4 xr[19];
#pragma unroll
        for (int q = 0; q < 19; ++q) { const int tt = t0 - 3 + q; const int tc = tt < 0 ? 0 : tt;
            u32x4 v = *(const u32x4*)(P + ((size_t)b * SEQ + tc) * PE + col);
            if (tt < 0) v = (u32x4){0u, 0u, 0u, 0u};
            xr[q] = v; }
#pragma unroll
        for (int i = 0; i < 16; ++i) {
            float acc[8]; for (int e = 0; e < 8; ++e) acc[e] = 0.f;
#pragma unroll
            for (int tp = 0; tp < 4; ++tp) { const u32x4 x = xr[i + tp]; const f32x4 w0 = wl[tp][0], w1 = wl[tp][1];
                acc[0] += w0[0] * bflo(x.x); acc[1] += w0[1] * bfhi(x.x); acc[2] += w0[2] * bflo(x.y); acc[3] += w0[3] * bfhi(x.y);
                acc[4] += w1[0] * bflo(x.z); acc[5] += w1[1] * bfhi(x.z); acc[6] += w1[2] * bflo(x.w); acc[7] += w1[3] * bfhi(x.w); }
            float ss = 0.f;
            for (int e = 0; e < 8; ++e) { acc[e] = acc[e] * sigmoidf_(acc[e]); ss += acc[e] * acc[e]; }
            ss += shx(ss, 1); ss += shx(ss, 2); ss += shx(ss, 4); ss += shx(ss, 8);
            if (part < 2) { const float rn = rsqrtf(ss + EPS); for (int e = 0; e < 8; ++e) acc[e] *= rn; }
            u32x4 o; o.x = pk2(acc[0], acc[1]); o.y = pk2(acc[2], acc[3]); o.z = pk2(acc[4], acc[5]); o.w = pk2(acc[6], acc[7]);
            lst<u32x4>(lds, part * 17408 + (rb * 16 + i) * 272 + sub * 16, o);
        }
    }
    __syncthreads();
    {
        const int ct = lw >> 1, st = lw & 1;
        if (st <= ct) {
            f32x16 acc = zero16();
#pragma unroll
            for (int ks = 0; ks < 8; ++ks) { const bf16x8 a = lld<bf16x8>(lds, T1_K + (32 * ct + r) * 272 + (16 * ks + 8 * hh) * 2), bq = lld<bf16x8>(lds, T1_K + (32 * st + r) * 272 + (16 * ks + 8 * hh) * 2); acc = mfma32(a, bq, acc); }
            const int s = 32 * st + r; const float gcs = lld<float>(lds, T1_GC + s * 4);
#pragma unroll
            for (int i = 0; i < 16; ++i) { const int c = 32 * ct + crow(i, hh);
                const float val = (s < c) ? acc[i] * lld<float>(lds, T1_BETA + c * 4) * __expf(lld<float>(lds, T1_GC + c * 4) - gcs) : 0.f;
                lst<float>(lds, T1_L + (c * 68 + s) * 4, val); }
        }
    }
    {
        const int st = lw >> 1, ct = lw & 1;
        f32x16 acc = zero16();
#pragma unroll
        for (int ks = 0; ks < 8; ++ks) { const bf16x8 a = lld<bf16x8>(lds, T1_K + (32 * st + r) * 272 + (16 * ks + 8 * hh) * 2), bq = lld<bf16x8>(lds, T1_Q + (32 * ct + r) * 272 + (16 * ks + 8 * hh) * 2); acc = mfma32(a, bq, acc); }
        const int c = 32 * ct + r; const float gcc = lld<float>(lds, T1_GC + c * 4);
#pragma unroll
        for (int i = 0; i < 16; ++i) { const int s = 32 * st + crow(i, hh);
            acc[i] = (s <= c) ? acc[i] * QSCALE * __expf(gcc - lld<float>(lds, T1_GC + s * 4)) : 0.f; }
#pragma unroll
        for (int half = 0; half < 2; ++half) { const bf16x8 f = pack8(acc, half); const int ksp = 2 * st + half;
            *(bf16x8*)(qkrec + ((ct * 4 + ksp) * 64 + lane) * 16) = f; }
    }
    {
        const int w2 = lw;
#pragma unroll
        for (int q = 0; q < 4; ++q) {
            const int rt = q & 1, ks = 2 * w2 + (q >> 1); const int c = 32 * rt + r; const float sc = QSCALE * lld<float>(lds, T1_EGC + c * 4);
            const u32x2 a = lld<u32x2>(lds, T1_Q + c * 272 + (16 * ks + 4 * hh) * 2), bq = lld<u32x2>(lds, T1_Q + c * 272 + (16 * ks + 8 + 4 * hh) * 2);
            u32x4 o; o.x = pk2(bflo(a.x) * sc, bfhi(a.x) * sc); o.y = pk2(bflo(a.y) * sc, bfhi(a.y) * sc); o.z = pk2(bflo(bq.x) * sc, bfhi(bq.x) * sc); o.w = pk2(bflo(bq.y) * sc, bfhi(bq.y) * sc);
            *(u32x4*)(rec + 16384 + ((rt * 8 + ks) * 64 + lane) * 16) = o;
        }
        const float gl = lld<float>(lds, T1_GC + 63 * 4);
#pragma unroll
        for (int ksp = 0; ksp < 4; ++ksp) {
            float v[8];
#pragma unroll
            for (int jx = 0; jx < 8; ++jx) { const int c = krow(ksp, hh, jx); v[jx] = bf2f(lld<unsigned short>(lds, T1_K + c * 272 + (32 * w2 + r) * 2)) * __expf(gl - lld<float>(lds, T1_GC + c * 4)); }
            u32x4 o; o.x = pk2(v[0], v[1]); o.y = pk2(v[2], v[3]); o.z = pk2(v[4], v[5]); o.w = pk2(v[6], v[7]);
            *(u32x4*)(rec + 32768 + ((w2 * 4 + ksp) * 64 + lane) * 16) = o;
        }
    }
    __syncthreads();
    if (lw == 0) {
        float x[64];
        x[0] = (lane == 0) ? 1.f : 0.f;
        f32x4 lo[8], nlo[8], hi[8];
        lo[0] = lld<f32x4>(lds, T1_L + (1 * 68) * 4);
        auto row = [&](auto CC) {
            constexpr int c = decltype(CC)::value;
            constexpr int nch = (c + 3) / 4, nnx = (c + 4) / 4;
#pragma unroll
            for (int s4 = 8; s4 < 16; ++s4) if (s4 < nch) hi[s4 - 8] = lld<f32x4>(lds, T1_L + (c * 68 + 4 * s4) * 4);
            if (c + 1 < 64) {
#pragma unroll
                for (int s4 = 0; s4 < 8; ++s4) if (s4 < nnx) nlo[s4] = lld<f32x4>(lds, T1_L + ((c + 1) * 68 + 4 * s4) * 4);
            }
            __builtin_amdgcn_sched_barrier(0);
            float a = (c == lane) ? 1.f : 0.f;
            f32x4 pa = {0.f, 0.f, 0.f, 0.f};
#pragma unroll
            for (int s4 = 0; s4 < 8; ++s4) if (s4 < nch) {
#pragma unroll
                for (int e = 0; e < 4; ++e) if (4 * s4 + e < c) pa[e] += lo[s4][e] * x[4 * s4 + e]; }
#pragma unroll
            for (int s4 = 8; s4 < 16; ++s4) if (s4 < nch) {
#pragma unroll
                for (int e = 0; e < 4; ++e) if (4 * s4 + e < c) pa[e] += hi[s4 - 8][e] * x[4 * s4 + e]; }
            a -= (pa[0] + pa[1]) + (pa[2] + pa[3]);
            x[c] = a;
            __builtin_amdgcn_sched_barrier(0);
#pragma unroll
            for (int s4 = 0; s4 < 8; ++s4) if (s4 < nnx) lo[s4] = nlo[s4];
        };
        for_const<1, 64>(row);
        const float bt = lld<float>(lds, T1_BETA + lane * 4), bte = bt * lld<float>(lds, T1_EGC + lane * 4);
#pragma unroll
        for (int c = 0; c < 64; ++c) {
            lst<unsigned short>(lds, T1_Q + c * 144 + lane * 2, (unsigned short)(pk2(x[c] * bt, 0.f) & 0xffffu));
            lst<unsigned short>(lds, T1_L + c * 144 + lane * 2, (unsigned short)(pk2(x[c] * bte, 0.f) & 0xffffu));
        }
    }
    __syncthreads();
    {
        const int dvt = lw, q4 = (lane & 15) >> 2, p4 = lane & 3, g1 = (lane >> 4) & 1;
        const int boff = (8 * hh + q4) * 272 + (32 * dvt + 16 * g1 + 4 * p4) * 2;
        f32x16 wacc[2];
#pragma unroll
        for (int rt = 0; rt < 2; ++rt) {
            f32x16 ua = zero16(); wacc[rt] = zero16();
#pragma unroll
            for (int ks = 0; ks < 4; ++ks) {
                const bf16x8 au = lld<bf16x8>(lds, T1_Q + (32 * rt + r) * 144 + (16 * ks + 8 * hh) * 2), aw = lld<bf16x8>(lds, T1_L + (32 * rt + r) * 144 + (16 * ks + 8 * hh) * 2);
                const s16x4 vlo = vtr(lds + T1_V + (16 * ks) * 272 + boff), vhi = vtr(lds + T1_V + (16 * ks + 4) * 272 + boff);
                const s16x4 klo = vtr(lds + T1_K + (16 * ks) * 272 + boff), khi = vtr(lds + T1_K + (16 * ks + 4) * 272 + boff);
                ua = mfma32(au, __builtin_shufflevector(vlo, vhi, 0, 1, 2, 3, 4, 5, 6, 7), ua);
                wacc[rt] = mfma32(aw, __builtin_shufflevector(klo, khi, 0, 1, 2, 3, 4, 5, 6, 7), wacc[rt]);
            }
            u32x4 o0, o1;
            o0.x = pk2(ua[0], ua[1]); o0.y = pk2(ua[2], ua[3]); o0.z = pk2(ua[4], ua[5]); o0.w = pk2(ua[6], ua[7]);
            o1.x = pk2(ua[8], ua[9]); o1.y = pk2(ua[10], ua[11]); o1.z = pk2(ua[12], ua[13]); o1.w = pk2(ua[14], ua[15]);
            unsigned char* up = rec + 49152 + ((rt * 4 + dvt) * 64 + lane) * 32;
            *(u32x4*)up = o0; *(u32x4*)(up + 16) = o1;
        }
        __syncthreads();
#pragma unroll
        for (int rt = 0; rt < 2; ++rt)
#pragma unroll
            for (int i = 0; i < 16; ++i) lst<unsigned short>(lds, T1_Q + (32 * rt + crow(i, hh)) * 272 + (32 * dvt + r) * 2, (unsigned short)(pk2(wacc[rt][i], 0.f) & 0xffffu));
    }
    __syncthreads();
    {
#pragma unroll
        for (int q = 0; q < 4; ++q) { const int f = lw * 4 + q, rt = f & 1, ks = f >> 1; const int c = 32 * rt + r;
            const u32x2 a = lld<u32x2>(lds, T1_Q + c * 272 + (16 * ks + 4 * hh) * 2), bq = lld<u32x2>(lds, T1_Q + c * 272 + (16 * ks + 8 + 4 * hh) * 2);
            u32x4 o; o.x = a.x; o.y = a.y; o.z = bq.x; o.w = bq.y;
            *(u32x4*)(rec + ((rt * 8 + ks) * 64 + lane) * 16) = o; }
        if (lt == 0) ((float*)(p.ws + WS_GL))[unit] = lld<float>(lds, T1_EGC + 63 * 4);
    }
    __syncthreads();
}

constexpr int SC_BUF = 57344;
DI void scan_unit(const Params& p, int b, int h, lptr lds) {
    bf16_t* P = (bf16_t*)(p.ws + WS_P);
    const int tid = tid_(), w = tid >> 6, lane = tid & 63, r = lane & 31, hh = lane >> 5;
    const int bh = b * 4 + h;
    const unsigned char* rec0 = p.ws + WS_REC + (size_t)bh * 64 * 65536;
    const unsigned char* qk0 = p.ws + WS_QK + (size_t)bh * 64 * 8192;
    const float* GL = (const float*)(p.ws + WS_GL) + bh * 64;
    auto stage = [&](int n) {
        const int lt = tid - 256; const lptr dst = lds + (n & 1) * SC_BUF;
        const unsigned char* src = rec0 + (size_t)n * 65536; const unsigned char* qsrc = qk0 + (size_t)n * 8192;
        u32x4 v[14];
#pragma unroll
        for (int i = 0; i < 12; ++i) v[i] = *(const u32x4*)(src + (lt + 256 * i) * 16);
#pragma unroll
        for (int i = 0; i < 2; ++i) v[12 + i] = *(const u32x4*)(qsrc + (lt + 256 * i) * 16);
#pragma unroll
        for (int i = 0; i < 12; ++i) lst<u32x4>(dst, (lt + 256 * i) * 16, v[i]);
#pragma unroll
        for (int i = 0; i < 2; ++i) lst<u32x4>(dst, 49152 + (lt + 256 * i) * 16, v[12 + i]);
    };
    f32x16 S[4]; for (int d = 0; d < 4; ++d) S[d] = zero16();
    if (w >= 4) stage(0);
#pragma unroll 1
    for (int n = 0; n < 64; ++n) {
        __syncthreads();
        if (w < 4) {
            const lptr buf = lds + (n & 1) * SC_BUF; const int dvt = w;
            const unsigned char* urec = rec0 + (size_t)n * 65536 + 49152;
            u32x4 ur[2][2];
#pragma unroll
            for (int rt = 0; rt < 2; ++rt) { const unsigned char* up = urec + ((rt * 4 + dvt) * 64 + lane) * 32; ur[rt][0] = *(const u32x4*)up; ur[rt][1] = *(const u32x4*)(up + 16); }
            const float gl = GL[n];
            f32x16 ws[2], o[2]; ws[0] = zero16(); ws[1] = zero16(); o[0] = zero16(); o[1] = zero16();
#pragma unroll
            for (int ks = 0; ks < 8; ++ks) { const bf16x8 sf = pack8(S[ks >> 1], ks & 1);
#pragma unroll
                for (int rt = 0; rt < 2; ++rt) { const bf16x8 wf = lld<bf16x8>(buf, ((rt * 8 + ks) * 64 + lane) * 16), qf = lld<bf16x8>(buf, 16384 + ((rt * 8 + ks) * 64 + lane) * 16);
                    ws[rt] = mfma32(wf, sf, ws[rt]); o[rt] = mfma32(qf, sf, o[rt]); } }
            f32x16 vn[2];
#pragma unroll
            for (int rt = 0; rt < 2; ++rt) {
                const unsigned uw[8] = {ur[rt][0].x, ur[rt][0].y, ur[rt][0].z, ur[rt][0].w, ur[rt][1].x, ur[rt][1].y, ur[rt][1].z, ur[rt][1].w};
#pragma unroll
                for (int q = 0; q < 8; ++q) { vn[rt][2 * q] = bflo(uw[q]) - ws[rt][2 * q]; vn[rt][2 * q + 1] = bfhi(uw[q]) - ws[rt][2 * q + 1]; }
            }
            bf16x8 vf[4];
#pragma unroll
            for (int ksp = 0; ksp < 4; ++ksp) vf[ksp] = pack8(vn[ksp >> 1], ksp & 1);
#pragma unroll
            for (int rt = 0; rt < 2; ++rt)
#pragma unroll
                for (int ksp = 0; ksp < 4; ++ksp) o[rt] = mfma32(lld<bf16x8>(buf, 49152 + ((rt * 4 + ksp) * 64 + lane) * 16), vf[ksp], o[rt]);
#pragma unroll
            for (int d = 0; d < 4; ++d) { S[d] *= gl;
#pragma unroll
                for (int ksp = 0; ksp < 4; ++ksp) S[d] = mfma32(lld<bf16x8>(buf, 32768 + ((d * 4 + ksp) * 64 + lane) * 16), vf[ksp], S[d]); }
#pragma unroll
            for (int rt = 0; rt < 2; ++rt)
#pragma unroll
                for (int i = 0; i < 16; ++i) { const size_t tok = (size_t)b * SEQ + 64 * n + 32 * rt + crow(i, hh);
                    P[tok * PE + 1024 + h * 128 + 32 * dvt + r] = (bf16_t)(pk2(o[rt][i], 0.f) & 0xffffu); }
        } else if (n + 1 < 64) stage(n + 1);
    }
    __syncthreads();
}

DI void phase_post(const Params& p, int L) {
    const int j = L >> 1;
    const bf16_t* P = (const bf16_t*)(p.ws + WS_P); bf16_t* O = (bf16_t*)(p.ws + WS_O);
    const int tid = tid_(), wave = tid >> 6, lane = tid & 63;
    const float lambda_init = 0.8f - 0.6f * __expf(-0.3f * (float)L);
    const float s1 = wave_sum(p.in[11][j * 64 + lane] * p.in[12][j * 64 + lane]), s2 = wave_sum(p.in[13][j * 64 + lane] * p.in[14][j * 64 + lane]);
    const float lam = expf(s1) - expf(s2) + lambda_init;
    const bool isa = lane < 32; const int d0 = (lane & 7) * 16;
    float nw[16];
    { const float* src = isa ? (p.in[10] + j * 128 + d0) : (p.in[15] + j * 128 + d0); for (int e = 0; e < 16; ++e) nw[e] = src[e] * (isa ? 1.f : (1.f - lambda_init)); }
    for (int row = bid_() * 8 + wave; row < MTOK; row += gridDim.x * 8) {
        const bf16_t* pr = P + (size_t)row * PE;
        float o[16];
        if (isa) { const u32x4 a = *(const u32x4*)(pr + 1024 + 16 * lane), bq = *(const u32x4*)(pr + 1024 + 16 * lane + 8);
            const unsigned uw[8] = {a.x, a.y, a.z, a.w, bq.x, bq.y, bq.z, bq.w};
            for (int q = 0; q < 8; ++q) { o[2 * q] = bflo(uw[q]); o[2 * q + 1] = bfhi(uw[q]); } }
        else { const int l2 = lane - 32;
            const u32x4 a = *(const u32x4*)(pr + 16 * l2), bq = *(const u32x4*)(pr + 16 * l2 + 8), c = *(const u32x4*)(pr + 512 + 16 * l2), d = *(const u32x4*)(pr + 512 + 16 * l2 + 8);
            const unsigned u1[8] = {a.x, a.y, a.z, a.w, bq.x, bq.y, bq.z, bq.w}, u2[8] = {c.x, c.y, c.z, c.w, d.x, d.y, d.z, d.w};
            for (int q = 0; q < 8; ++q) { o[2 * q] = bflo(u1[q]) - lam * bflo(u2[q]); o[2 * q + 1] = bfhi(u1[q]) - lam * bfhi(u2[q]); } }
        float ss = 0.f; for (int e = 0; e < 16; ++e) ss += o[e] * o[e];
        ss += shx(ss, 1); ss += shx(ss, 2); ss += shx(ss, 4);
        const float rn = rsqrtf(ss * (1.f / 128.f) + EPS);
        float g[16];
        if (isa) { const u32x4 a = *(const u32x4*)(pr + 1536 + 16 * lane), bq = *(const u32x4*)(pr + 1536 + 16 * lane + 8);
            const unsigned uw[8] = {a.x, a.y, a.z, a.w, bq.x, bq.y, bq.z, bq.w};
            for (int q = 0; q < 8; ++q) { const float z0 = bflo(uw[q]), z1 = bfhi(uw[q]); g[2 * q] = z0 * sigmoidf_(z0); g[2 * q + 1] = z1 * sigmoidf_(z1); } }
        else for (int e = 0; e < 16; ++e) g[e] = 1.f;
        for (int e = 0; e < 16; ++e) o[e] = o[e] * rn * nw[e] * g[e];
        u32x4 w0, w1; w0.x = pk2(o[0], o[1]); w0.y = pk2(o[2], o[3]); w0.z = pk2(o[4], o[5]); w0.w = pk2(o[6], o[7]);
        w1.x = pk2(o[8], o[9]); w1.y = pk2(o[10], o[11]); w1.z = pk2(o[12], o[13]); w1.w = pk2(o[14], o[15]);
        *(u32x4*)(O + (size_t)row * DM + 16 * lane) = w0; *(u32x4*)(O + (size_t)row * DM + 16 * lane + 8) = w1;
    }
}

DI int next_unit(int* ctr, lptr lds) {
    __syncthreads();
    if (tid_() == 0) lst<int>(lds, LDS_UNIT_WORD, atomicAdd(ctr, 1));
    __syncthreads();
    return lld<int>(lds, LDS_UNIT_WORD);
}


#define XB_TMO      128
#define XB_XCNT(j)  (256  + 64 * (j))
#define XB_XSUB(j)  (1280 + 64 * (j))
#define XB_XGEN(j)  (2304 + 64 * (j))
#define XB_TOP      3328
#define XB_TOPGEN   3392
#define XCD_BAR_WORDS 3456
#define XB_SPIN_CAP (1u << 22)
DI unsigned xb_ld(unsigned* p)              { return __hip_atomic_load(p, __ATOMIC_RELAXED, __HIP_MEMORY_SCOPE_AGENT); }
DI unsigned xb_add(unsigned* p, unsigned v) { return __hip_atomic_fetch_add(p, v, __ATOMIC_RELAXED, __HIP_MEMORY_SCOPE_AGENT); }
DI unsigned xb_xcc_id() { return (unsigned)__builtin_amdgcn_s_getreg((3 << 11) | 20) & 0xFu; }
#define XB_SPIN(cond, bar) do { unsigned _sp = 0; while (cond) { __builtin_amdgcn_s_sleep(1); \
    if ((++_sp & 255u) == 0u) { if (xb_ld(&(bar)[XB_TMO])) break; if (_sp > XB_SPIN_CAP) { atomicAdd(&(bar)[XB_TMO], 1u); break; } } } } while (0)
struct XcdBarrier { unsigned* bar; unsigned x; volatile LAS unsigned* st; };
DI XcdBarrier xcd_barrier_post(unsigned* bar, volatile LAS unsigned* st) {
    XcdBarrier b; b.bar = bar; b.x = xb_xcc_id(); b.st = st;
    if (threadIdx.x == 0) (void)xb_add(&bar[XB_XCNT(b.x)], 1u);
    return b;
}
DI void xcd_barrier_complete(unsigned* bar, unsigned x, unsigned& nloc, unsigned& nx) {
    const unsigned G = gridDim.x * gridDim.y * gridDim.z;
    unsigned sum, cnt, mine, sp = 0u;
    for (;;) {
        sum = 0u; cnt = 0u; mine = 0u;
#pragma unroll
        for (unsigned j = 0; j < 16; ++j) { const unsigned c = xb_ld(&bar[XB_XCNT(j)]); sum += c; cnt += (c > 0u) ? 1u : 0u; mine = (j == x) ? c : mine; }
        if (sum == G) break;
        __builtin_amdgcn_s_sleep(1);
        if ((++sp & 255u) == 0u) { if (xb_ld(&bar[XB_TMO])) break; if (sp > XB_SPIN_CAP) { atomicAdd(&bar[XB_TMO], 1u); break; } }
    }
    nloc = mine > 0u ? mine : 1u; nx = cnt > 0u ? cnt : 1u;
}
DI void xcd_barrier(const XcdBarrier& b) {
    asm volatile("s_waitcnt vmcnt(0)" ::: "memory");
    __syncthreads();
    if (threadIdx.x == 0) {
        unsigned* bar = b.bar;
        __builtin_amdgcn_s_waitcnt(0);
        unsigned nloc = b.st[0], nx = b.st[1];
        if (nloc == 0u) { xcd_barrier_complete(bar, b.x, nloc, nx); b.st[0] = nloc; b.st[1] = nx; }
        const unsigned old = xb_add(&bar[XB_XSUB(b.x)], 1u);
        const unsigned gen = old / nloc;
        if (old + 1u == (gen + 1u) * nloc) {
            __builtin_amdgcn_fence(__ATOMIC_RELEASE, "agent");
            asm volatile("s_waitcnt vmcnt(0)" ::: "memory");
            const unsigned og = xb_add(&bar[XB_TOP], 1u);
            const unsigned tg = og / nx;
            if (og + 1u == (tg + 1u) * nx) xb_add(&bar[XB_TOPGEN], 1u);
            else XB_SPIN(xb_ld(&bar[XB_TOPGEN]) == tg, bar);
            __builtin_amdgcn_fence(__ATOMIC_ACQUIRE, "agent");
            xb_add(&bar[XB_XGEN(b.x)], 1u);
            asm volatile("s_waitcnt vmcnt(0)" ::: "memory");
        } else {
            XB_SPIN(xb_ld(&bar[XB_XGEN(b.x)]) == gen, bar);
            __builtin_amdgcn_fence(__ATOMIC_ACQUIRE, "agent");
            asm volatile("s_waitcnt vmcnt(0)" ::: "memory");
        }
    }
    __syncthreads();
}

#ifndef PROBE
#define PROBE 0
#endif
#define GSYNC() do { xcd_barrier(xb); if (PROBE == 3) xcd_barrier(xb); } while (0)
__global__ void __launch_bounds__(512) mega(Params p) {
    extern __shared__ __attribute__((aligned(16))) unsigned char smem_raw[];
    const lptr lds = (lptr)smem_raw;
    cg::grid_group grid = cg::this_grid();
    float* X = p.out;
    bf16_t* H = (bf16_t*)(p.ws + WS_H); bf16_t* Pb = (bf16_t*)(p.ws + WS_P); bf16_t* O = (bf16_t*)(p.ws + WS_O); bf16_t* PB = (bf16_t*)(p.ws + WS_PB);
    float* GATE = (float*)(p.ws + WS_GATE);
    bf16_t* Wt_in = (bf16_t*)(p.ws + WS_W + W_IN); bf16_t* Wt_out = (bf16_t*)(p.ws + WS_W + W_OUT); bf16_t* Wt_up = (bf16_t*)(p.ws + WS_W + W_UP);
    bf16_t* Wt_down = (bf16_t*)(p.ws + WS_W + W_DOWN); bf16_t* Wt_ple = (bf16_t*)(p.ws + WS_W + W_PLE); bf16_t* Wt_gate = (bf16_t*)(p.ws + WS_W + W_GATE);
    int* ctr = (int*)(p.ws + WS_CTL);
    float* SSb = (float*)(p.ws + WS_SS);

    if (tid_() == 0) { lst<unsigned>(lds, LDS_UNIT_WORD + 16, 0u); lst<unsigned>(lds, LDS_UNIT_WORD + 20, 0u); }
    __syncthreads();
    const XcdBarrier xb = xcd_barrier_post((unsigned*)(p.ws + WS_CTL + 4096), (volatile LAS unsigned*)(lds + LDS_UNIT_WORD + 16));
    phase_prologue(p);
    if (p.ws == nullptr) grid.sync();
    GSYNC();
#pragma unroll 1
    for (int L = 0; L < 4; ++L) {
        const bool even = !(L & 1); const int j = L >> 1;
        const float* Xin = (L == 0) ? p.in[0] : X;
        const float* Win = even ? (p.in[6] + (size_t)j * 1024 * EVEN_IN) : (p.in[17] + (size_t)j * 1024 * ODD_IN);
        const int ldw = even ? EVEN_IN : ODD_IN; const int NIN = even ? PE : PO;
        for (int rep1 = 0; rep1 < (PROBE == 5 ? 2 : 1); ++rep1) {
        phase_norm(Xin, p.in[3] + L * 1024, H, Win, ldw, even ? 2048 : 4096, GATE, lds);
        {
            const int n_in = 16 * (NIN / 256);
            const int c1 = n_in, c2 = c1 + 64, c3 = c2 + 256, c4 = c3 + 256, c5 = c4 + 16, c6 = c5 + 64;
            for (int g = bid_(); g < c6; g += gridDim.x) {
                ConvJob J;
                if (g < c1)      { J = ConvJob{Win, Wt_in, nullptr, 1024, ldw, NIN, even ? 2048 : (1 << 30), even ? 2048 : 0, even ? 3072 : 0}; conv_tile(J, g, lds); }
                else if (g < c2) { J = ConvJob{(even ? p.in[16] : p.in[19]) + (size_t)j * 1024 * 1024, Wt_out, nullptr, 1024, 1024, 1024, 1 << 30, 0, 0}; conv_tile(J, g - c1, lds); }
                else if (g < c3) { J = ConvJob{p.in[20] + (size_t)L * 1024 * 4096, Wt_up, p.in[4] + L * 1024, 1024, 4096, 4096, 1 << 30, 0, 0}; conv_tile(J, g - c2, lds); }
                else if (g < c4) { J = ConvJob{p.in[21] + (size_t)L * 4096 * 1024, Wt_down, nullptr, 4096, 1024, 1024, 1 << 30, 0, 0}; conv_tile(J, g - c3, lds); }
                else if (g < c5) { J = ConvJob{p.in[22] + (size_t)L * 256 * 1024, Wt_ple, nullptr, 256, 1024, 1024, 1 << 30, 0, 0}; conv_tile(J, g - c4, lds); }
                else             { J = ConvJob{p.in[23] + (size_t)L * 1024 * 1024, Wt_gate, nullptr, 1024, 1024, 1024, 1 << 30, 0, 0}; conv_tile(J, g - c5, lds); }
            }
            for (int i = bid_() * 512 + tid_(); i < MTOK; i += gridDim.x * 512) SSb[i] = 0.f;
        }
        { const float* ps = p.in[1] + (size_t)L * MTOK * 256;
            for (size_t i = (size_t)bid_() * 512 + tid_(); i < (size_t)MTOK * 256 / 4; i += (size_t)gridDim.x * 512) { const f32x4 v = *(const f32x4*)(ps + i * 4); u32x2 w; w.x = pk2(v[0], v[1]); w.y = pk2(v[2], v[3]); *(u32x2*)(PB + i * 4) = w; } }
        }
        GSYNC();
        if (!even) phase_cumsum(p, j, lds);
        { EpiInProj E{Pb, NIN, even ? 2048 : 0, even ? 3072 : 0, (const float*)(p.ws + WS_COS), (const float*)(p.ws + WS_SIN)}; run_gemm(lds, H, Wt_in, NIN, 1024, E); }
        GSYNC();
        if (even) {
            { const int team = __builtin_amdgcn_readfirstlane(tid_() >> 8);
              for (int u2 = bid_(); u2 < 1024; u2 += gridDim.x) g1_team(p, j, 2047 - (2 * u2 + team), lds + team * T1_STRIDE); }
            GSYNC();
            for (int rep = 0; rep < (PROBE == 2 ? 2 : 1); ++rep) for (;;) { const int u = next_unit(ctr + L + 8 * rep, lds); if (u >= 32 + 1024) break;
                if (u < 32) scan_unit(p, u >> 2, u & 3, lds);
                else { const int a = u - 32, qb = 15 - (a >> 6), idx = a & 63, b = idx >> 3, hd = (idx >> 1) & 3, mp = idx & 1;
                    attn_unit<64, false>(Pb, PE, b, qb, 2048 + hd * 128 + mp * 64, 2560 + hd * 128 + mp * 64, 3072 + hd * 128, Pb, PE, mp * 512 + hd * 128, 0, nullptr, lds); } }
            GSYNC();
            for (int rep4 = 0; rep4 < (PROBE == 4 ? 2 : 1); ++rep4) phase_post(p, L);
        } else {
            for (int rep = 0; rep < (PROBE == 2 ? 2 : 1); ++rep) for (;;) { const int u = next_unit(ctr + L + 8 * rep, lds); if (u >= 1024) break;
                const int qb = 15 - (u >> 6), idx = u & 63, b = idx >> 3, hd = idx & 7;
                attn_unit<128, true>(Pb, PO, b, qb, hd * 128, 1024 + hd * 128, 2048 + hd * 128, O, DM, hd * 128, 3072 + hd * 128, (const float*)(p.ws + WS_CUM) + (size_t)idx * SEQ, lds); }
        }
        GSYNC();
        if (PROBE == 1) { EpiStore<0> E{Pb, 1024, nullptr}; run_gemm(lds, O, Wt_out, 1024, 1024, E); }
        { EpiResid E{Xin, X, H, SSb}; run_gemm_rev(lds, O, Wt_out, 1024, 1024, E); }
        GSYNC();
        for (int rep = 0; rep < (PROBE == 1 ? 2 : 1); ++rep) { EpiStore<1> E{Pb, 4096, SSb}; run_gemm(lds, H, Wt_up, 4096, 1024, E); }
        GSYNC();
        if (PROBE == 1) { EpiStore<0> E{O, 1024, nullptr}; run_gemm(lds, Pb, Wt_down, 1024, 4096, E); }
        { EpiResid E{X, X, H, nullptr}; run_gemm_rev(lds, Pb, Wt_down, 1024, 4096, E); }
        GSYNC();
        { EpiStore<2> E{O, 1024, nullptr}; run_gemm(lds, H, Wt_gate, 1024, 1024, E); }
        if (PROBE == 1) { EpiStore<0> E{H, 1024, nullptr}; run_gemm(lds, PB, Wt_ple, 1024, 256, E); }
        { EpiPle E{X, O}; run_gemm(lds, PB, Wt_ple, 1024, 256, E); }
        GSYNC();
    }
    phase_final_norm(X, p.in[5]);
}

extern "C" void kernel_launch(void* const* d_in, const int* in_sizes, int n_in, void* d_out, int out_size, void* d_ws, size_t ws_size, hipStream_t stream) {
    static int grid_blocks = 0;
    if (!grid_blocks) {
        int dev = 0, cus = 0, per_cu = 0;
        hipGetDevice(&dev);
        hipDeviceGetAttribute(&cus, hipDeviceAttributeMultiprocessorCount, dev);
        hipFuncSetAttribute((const void*)mega, hipFuncAttributeMaxDynamicSharedMemorySize, LDS_BYTES);
        hipOccupancyMaxActiveBlocksPerMultiprocessor(&per_cu, (const void*)mega, 512, LDS_BYTES);
        if (per_cu < 1) per_cu = 1;
        grid_blocks = cus * per_cu;
        if (ws_size < WS_END) fprintf(stderr, "kernel_launch: workspace too small: %zu < %zu\n", ws_size, (size_t)WS_END);
    }
    (void)hipMemsetAsync((char*)d_ws + WS_CTL, 0, 65536, stream);
    Params p{};
    for (int i = 0; i < 24; ++i) p.in[i] = (const float*)d_in[i];
    p.out = (float*)d_out; p.ws = (unsigned char*)d_ws;
    void* args[] = {&p};
    hipError_t e = hipLaunchCooperativeKernel((const void*)mega, dim3(grid_blocks), dim3(512), args, LDS_BYTES, stream);
    if (e != hipSuccess) fprintf(stderr, "cooperative launch failed: %s (grid %d)\n", hipGetErrorString(e), grid_blocks);
}
```

```cpp
#include <hip/hip_runtime.h>
#include <hip/hip_cooperative_groups.h>
#include <cstdio>
#include <cstdint>
#include <type_traits>
namespace cg = cooperative_groups;
namespace pg8 {
#define PG8_LAS __attribute__((address_space(3)))
typedef unsigned short bf16_t;
typedef short bf16x8 __attribute__((ext_vector_type(8)));
typedef float f32x4 __attribute__((ext_vector_type(4)));
typedef unsigned u32x4 __attribute__((ext_vector_type(4)));
constexpr int BM = 256, BK = 64, HALF = 128, HTB = HALF * BK * 2  , STAGE_BYTES = 8 * HTB, NXCD = 8, WGM = 8;

__host__ __device__ __forceinline__ int lds_byte(int r, int c) { const int st = (r >> 4) * 2 + (c >> 5), rr = r & 15, cc = c & 31, ob = rr * 64 + cc * 2; return st * 1024 + (ob ^ (((ob >> 9) & 1) << 5)); }
__host__ __device__ __forceinline__ void stage_rc(int b, int& R, int& C) { const int st = b / 1024, sb = b % 1024, swz = sb ^ (((sb >> 9) & 1) << 5); R = (st >> 1) * 16 + swz / 64; C = (st & 1) * 32 + (swz % 64) / 2; }
__host__ __device__ __forceinline__ int perm32(int rho) { const int n = rho >> 4, i = rho & 15; return 8 * (i >> 2) + 4 * n + (i & 3); }

struct Unit { int pm, pn; };
struct Gemm { const bf16_t* A; const bf16_t* Bt; int M, N, K; };

struct StaticOrder {
    int nM, nN, nwg, G, c;
    __host__ __device__ void init(int M, int N, int G_, int c_) { nM = M / BM; nN = N / BM; nwg = nM * nN; G = G_; c = c_; }
    __host__ __device__ bool next(int i, Unit& u) const {
        const long L = (long)i * G + c; if (L >= nwg) return false;
        int wgid = (int)L; { const int q = nwg / NXCD, r = nwg % NXCD, xcd = wgid % NXCD, off = wgid / NXCD; wgid = (xcd < r ? xcd * (q + 1) : r * (q + 1) + (xcd - r) * q) + off; }
        const int nig = WGM * nN, gid = wgid / nig, fm = gid * WGM, gsz = (nM - fm) < WGM ? (nM - fm) : WGM;
        u.pm = fm + ((wgid % nig) % gsz); u.pn = (wgid % nig) / gsz; return true;
    }
    __device__ __forceinline__ void a_ready(const Unit&) const {}
    __device__ __forceinline__ void done(const Unit&) const {}
};

__device__ __forceinline__ unsigned cvt_pk_bf16(float lo, float hi) { unsigned r; asm volatile("v_cvt_pk_bf16_f32 %0, %1, %2" : "=v"(r) : "v"(lo), "v"(hi)); return r; }
template <class Epi, class Sched, bool ALIGN_EPI = false, bool SP2 = false>
__device__ __forceinline__ void gemm_phase(PG8_LAS unsigned char* lds, const Gemm g, const Sched& S, const Epi& E) {
    int tid = threadIdx.x; asm volatile("" : "+v"(tid)); const int wid = __builtin_amdgcn_readfirstlane(tid >> 6), lane = tid & 63, wr = wid >> 2, wc = wid & 3, fr = lane & 15, fq = lane >> 4;
    const int K = g.K, nt = K / BK;
    unsigned voffA[2], voffB[2];
#pragma unroll
    for (int i = 0; i < 2; ++i) { int R, C; stage_rc(tid * 16 + i * 8192, R, C); const int Rb = Epi::PERM ? ((R & ~31) + perm32(R & 31)) : R;
        voffA[i] = (unsigned)(R * K + C) * 2u; voffB[i] = (unsigned)(Rb * K + C) * 2u; }
    const size_t kstep = (size_t)(BK * 2);
    const size_t hstep = (size_t)HALF * K * 2;
    const size_t tstep = 2 * hstep;
    const unsigned ldsw = (unsigned)wid * 1024u;
    const int aoff = lds_byte(wr * 64 + fr, fq * 8), boff = lds_byte(wc * 32 + fr, fq * 8);
#define PG8_SA(b, h) (((b) * 2 + (h)) * HTB)
#define PG8_SB(b, h) ((4 + (b) * 2 + (h)) * HTB)
#define PG8_STAGE(bufoff, gbase, voff) do { _Pragma("unroll") for (int _i = 0; _i < 2; ++_i) \
        __builtin_amdgcn_global_load_lds((const unsigned*)((const char*)(gbase) + (voff)[_i]), (PG8_LAS unsigned*)(lds + (bufoff) + ldsw + _i * 8192), 16, 0, 0); } while (0)
#define PG8_LDA(dst, b, h) do { _Pragma("unroll") for (int m = 0; m < 4; ++m) _Pragma("unroll") for (int k = 0; k < 2; ++k) dst[m][k] = *(const PG8_LAS bf16x8*)(lds + PG8_SA(b, h) + aoff + m * 2048 + k * 1024); } while (0)
#define PG8_LDB(dst, b, h) do { _Pragma("unroll") for (int n = 0; n < 2; ++n) _Pragma("unroll") for (int k = 0; k < 2; ++k) dst[n][k] = *(const PG8_LAS bf16x8*)(lds + PG8_SB(b, h) + boff + n * 2048 + k * 1024); } while (0)
#define PG8_MMA(ai, bj, At, Bt) do { __builtin_amdgcn_s_setprio(1); _Pragma("unroll") for (int m = 0; m < 4; ++m) _Pragma("unroll") for (int n = 0; n < 2; ++n) _Pragma("unroll") for (int k = 0; k < 2; ++k) \
        acc[ai][bj][m][n] = __builtin_amdgcn_mfma_f32_16x16x32_bf16(Bt[n][k], At[m][k], acc[ai][bj][m][n], 0, 0, 0); __builtin_amdgcn_s_setprio(0); } while (0)
#define PG8_WAIT_V(n) asm volatile("s_waitcnt vmcnt(" #n ")" ::: "memory")
#define PG8_WAIT_L(n) asm volatile("s_waitcnt lgkmcnt(" #n ")" ::: "memory")
#define PG8_BAR __builtin_amdgcn_s_barrier()
#define PG8_SCHED __builtin_amdgcn_sched_barrier(0)
    Unit cur, nxt; int ui = 0;
    if (!S.next(0, cur)) return;
    f32x4 acc[2][2][4][2];
#pragma unroll
    for (int a = 0; a < 2; ++a)
#pragma unroll
        for (int b = 0; b < 2; ++b)
#pragma unroll
            for (int m = 0; m < 4; ++m)
#pragma unroll
                for (int n = 0; n < 2; ++n) acc[a][b][m][n] = (f32x4){0.f, 0.f, 0.f, 0.f};
    bf16x8 At[4][2], B0[2][2], B1[2][2];
    const char* cA = (const char*)g.A + (size_t)cur.pm * tstep; const char* cB = (const char*)g.Bt + (size_t)cur.pn * tstep;
    S.a_ready(cur);
    if constexpr (SP2) {
        PG8_STAGE(PG8_SB(0, 0), cB, voffB); PG8_STAGE(PG8_SB(0, 1), cB + hstep, voffB); PG8_STAGE(PG8_SA(0, 0), cA, voffA); PG8_STAGE(PG8_SA(0, 1), cA + hstep, voffA);
        if (wr == 1) PG8_BAR;
        PG8_WAIT_V(2); PG8_BAR;
        PG8_STAGE(PG8_SB(1, 0), cB + kstep, voffB); PG8_STAGE(PG8_SA(1, 0), cA + kstep, voffA); PG8_STAGE(PG8_SB(1, 1), cB + hstep + kstep, voffB);
        PG8_WAIT_V(6); PG8_BAR;
    } else {
        PG8_STAGE(PG8_SB(0, 0), cB, voffB); PG8_STAGE(PG8_SA(0, 0), cA, voffA); PG8_STAGE(PG8_SB(0, 1), cB + hstep, voffB); PG8_STAGE(PG8_SA(0, 1), cA + hstep, voffA);
        if (wr == 1) PG8_BAR;
        PG8_WAIT_V(4); PG8_BAR;
        PG8_STAGE(PG8_SB(1, 0), cB + kstep, voffB); PG8_STAGE(PG8_SA(1, 0), cA + kstep, voffA); PG8_STAGE(PG8_SB(1, 1), cB + hstep + kstep, voffB);
        PG8_WAIT_V(6); PG8_BAR;
    }
    for (;;) {
        const bool has_next = S.next(ui + 1, nxt);
        const char* nA = has_next ? (const char*)g.A + (size_t)nxt.pm * tstep : cA; const char* nB = has_next ? (const char*)g.Bt + (size_t)nxt.pn * tstep : cB;
        for (int t = 0; t < nt; t += 2) {
            const bool last = (t == nt - 2);
            const char* a1 = cA + (size_t)(t + 1) * kstep;
            const char* a2 = last ? nA : cA + (size_t)(t + 2) * kstep; const char* b2 = last ? nB : cB + (size_t)(t + 2) * kstep;
            const char* a3 = a2 + kstep; const char* b3 = b2 + kstep;
            if (last && has_next) S.a_ready(nxt);
            if constexpr (SP2) {
            PG8_LDB(B0, 0, 0); PG8_LDB(B1, 0, 1); PG8_SCHED; PG8_LDA(At, 0, 0); PG8_STAGE(PG8_SA(1, 1), a1 + hstep, voffA);
            PG8_WAIT_V(8); PG8_WAIT_L(0); PG8_BAR; PG8_MMA(0, 0, At, B0); PG8_MMA(0, 1, At, B1); PG8_BAR; PG8_SCHED;
            PG8_LDA(At, 0, 1); PG8_STAGE(PG8_SB(0, 0), b2, voffB); PG8_STAGE(PG8_SB(0, 1), b2 + hstep, voffB); PG8_STAGE(PG8_SA(0, 0), a2, voffA);
            PG8_WAIT_V(8); PG8_WAIT_L(0); PG8_BAR; PG8_MMA(1, 0, At, B0); PG8_MMA(1, 1, At, B1); PG8_BAR; PG8_SCHED;
            PG8_LDB(B0, 1, 0); PG8_LDB(B1, 1, 1); PG8_SCHED; PG8_LDA(At, 1, 0); PG8_STAGE(PG8_SA(0, 1), a2 + hstep, voffA);
            PG8_WAIT_V(8); PG8_WAIT_L(0); PG8_BAR; PG8_MMA(0, 0, At, B0); PG8_MMA(0, 1, At, B1); PG8_BAR; PG8_SCHED;
            PG8_LDA(At, 1, 1); PG8_STAGE(PG8_SB(1, 0), b3, voffB); PG8_STAGE(PG8_SB(1, 1), b3 + hstep, voffB); PG8_STAGE(PG8_SA(1, 0), a3, voffA);
            PG8_WAIT_V(8); PG8_WAIT_L(0); PG8_BAR; PG8_MMA(1, 0, At, B0); PG8_MMA(1, 1, At, B1); PG8_BAR; PG8_SCHED;
            } else {
            PG8_LDB(B0, 0, 0); PG8_SCHED; PG8_LDA(At, 0, 0); PG8_STAGE(PG8_SA(1, 1), a1 + hstep, voffA);
            PG8_WAIT_L(8); PG8_BAR; PG8_WAIT_L(0); PG8_MMA(0, 0, At, B0); PG8_BAR; PG8_SCHED;
            PG8_LDB(B1, 0, 1); PG8_STAGE(PG8_SB(0, 0), b2, voffB);
            PG8_BAR; PG8_WAIT_L(0); PG8_MMA(0, 1, At, B1); PG8_BAR;
            PG8_LDA(At, 0, 1); PG8_STAGE(PG8_SA(0, 0), a2, voffA);
            PG8_BAR; PG8_WAIT_L(0); PG8_MMA(1, 0, At, B0); PG8_BAR; PG8_SCHED;
            PG8_STAGE(PG8_SB(0, 1), b2 + hstep, voffB);
            PG8_WAIT_V(6); PG8_BAR; PG8_MMA(1, 1, At, B1); PG8_BAR;
            PG8_LDB(B0, 1, 0); PG8_SCHED; PG8_LDA(At, 1, 0); PG8_STAGE(PG8_SA(0, 1), a2 + hstep, voffA);
            PG8_WAIT_L(8); PG8_BAR; PG8_WAIT_L(0); PG8_MMA(0, 0, At, B0); PG8_BAR; PG8_SCHED;
            PG8_LDB(B1, 1, 1); PG8_STAGE(PG8_SB(1, 0), b3, voffB);
            PG8_BAR; PG8_WAIT_L(0); PG8_MMA(0, 1, At, B1); PG8_BAR;
            PG8_LDA(At, 1, 1); PG8_STAGE(PG8_SA(1, 0), a3, voffA);
            PG8_BAR; PG8_WAIT_L(0); PG8_MMA(1, 0, At, B0); PG8_BAR; PG8_SCHED;
            PG8_STAGE(PG8_SB(1, 1), b3 + hstep, voffB);
            PG8_WAIT_V(6); PG8_BAR; PG8_MMA(1, 1, At, B1); PG8_BAR;
            }
        }
        if constexpr (ALIGN_EPI) { if (wr == 0) PG8_BAR; }
        if constexpr (!Epi::AFTER_DRAIN) { E(acc, cur, wr, wc, fr, fq); S.done(cur); }
        if (!has_next) break;
#pragma unroll
        for (int a = 0; a < 2; ++a)
#pragma unroll
            for (int b = 0; b < 2; ++b)
#pragma unroll
                for (int m = 0; m < 4; ++m)
#pragma unroll
                    for (int n = 0; n < 2; ++n) acc[a][b][m][n] = (f32x4){0.f, 0.f, 0.f, 0.f};
        cur = nxt; cA = nA; cB = nB; ++ui;
        if constexpr (ALIGN_EPI) { if (wr == 1) PG8_BAR; }
    }
    PG8_WAIT_V(0);
    if constexpr (!ALIGN_EPI) { if (wr == 0) PG8_BAR; }
    PG8_BAR;
    if constexpr (Epi::AFTER_DRAIN) { E.fused(acc, cur, wr, wc, fr, fq, lds, wid, lane); S.done(cur); }
#undef PG8_SA
#undef PG8_SB
#undef PG8_STAGE
#undef PG8_LDA
#undef PG8_LDB
#undef PG8_MMA
#undef PG8_WAIT_V
#undef PG8_WAIT_L
#undef PG8_BAR
#undef PG8_SCHED
}
}

#define DI __device__ __forceinline__
#define LAS __attribute__((address_space(3)))
typedef LAS unsigned char* lptr;
typedef unsigned short bf16_t;
typedef short bf16x8 __attribute__((ext_vector_type(8)));
typedef short s16x4 __attribute__((ext_vector_type(4)));
typedef float f32x4 __attribute__((ext_vector_type(4)));
typedef float f32x16 __attribute__((ext_vector_type(16)));
typedef unsigned u32x4 __attribute__((ext_vector_type(4)));
typedef unsigned u32x2 __attribute__((ext_vector_type(2)));
typedef float f32x2_t __attribute__((ext_vector_type(2)));
typedef __bf16 bf16x2_t __attribute__((ext_vector_type(2)));
using pg8::Unit;

constexpr int MTOK = 32768, SEQ = 4096, DM = 1024;
constexpr int EVEN_IN = 3592, ODD_IN = 4104;
constexpr int PE = 3584;
constexpr int PO = 4096;
constexpr float EPS = 1e-6f;
constexpr float LOG2E = 1.4426950408889634f;
constexpr float NEGBIG = -1e30f;
constexpr size_t MiB = 1u << 20;
constexpr size_t WS_CTL = 0, WS_GATE = 1 * MiB, WS_CUM = 2 * MiB, WS_GL = 3 * MiB, WS_COS = 4 * MiB, WS_SIN = 8 * MiB, WS_PB = 12 * MiB;
constexpr size_t WS_W = 28 * MiB, WS_O = 60 * MiB, WS_P = 124 * MiB, WS_H = 380 * MiB, WS_END = 512 * MiB;
constexpr size_t WS_SS = WS_GL + 512 * 1024;
constexpr size_t WS_REC = WS_H;
constexpr size_t WS_QK = WS_P + 224 * MiB;
constexpr size_t W_IN = 0, W_OUT = 8 * MiB, W_UP = 10 * MiB, W_DOWN = 18 * MiB, W_PLE = 26 * MiB, W_GATE = 27 * MiB;
constexpr int LDS_BYTES = 147456;
constexpr int LDS_UNIT_WORD = 147392;

struct Params { const float* in[24]; float* out; unsigned char* ws; };

DI unsigned pk2(float lo, float hi) { f32x2_t v = {lo, hi}; bf16x2_t b = __builtin_convertvector(v, bf16x2_t); return __builtin_bit_cast(unsigned, b); }
DI float bflo(unsigned w) { return __uint_as_float(w << 16); }
DI float bfhi(unsigned w) { return __uint_as_float(w & 0xffff0000u); }
DI float bf2f(unsigned short b) { return __uint_as_float(((unsigned)b) << 16); }
DI int crow(int i, int h) { return (i & 3) + 8 * (i >> 2) + 4 * h; }
DI int krow(int s, int h, int j) { return 16 * s + 8 * (j >> 2) + 4 * h + (j & 3); }
template <class T> DI T lld(lptr p, int off) { return *(const LAS T*)(p + off); }
template <class T> DI void lst(lptr p, int off, T v) { *(LAS T*)(p + off) = v; }
DI f32x16 mfma32(bf16x8 a, bf16x8 b, f32x16 c) { return __builtin_amdgcn_mfma_f32_32x32x16_bf16(a, b, c, 0, 0, 0); }
DI bf16x8 pack8(const f32x16& x, int s) {
    u32x4 p; p.x = pk2(x[8 * s], x[8 * s + 1]); p.y = pk2(x[8 * s + 2], x[8 * s + 3]); p.z = pk2(x[8 * s + 4], x[8 * s + 5]); p.w = pk2(x[8 * s + 6], x[8 * s + 7]);
    return __builtin_bit_cast(bf16x8, p);
}
DI s16x4 vtr(lptr p) { return __builtin_bit_cast(s16x4, __builtin_amdgcn_ds_read_tr16_b64_v4i16((LAS s16x4*)p)); }
DI int tid_() { int t = threadIdx.x; asm volatile("" : "+v"(t)); return t; }
DI float shx(float v, int m) { const int lane = tid_() & 63; return __builtin_bit_cast(float, __builtin_amdgcn_ds_bpermute((lane ^ m) << 2, __builtin_bit_cast(int, v))); }
DI float wave_sum(float v) { v += shx(v, 32); v += shx(v, 16); v += shx(v, 8); v += shx(v, 4); v += shx(v, 2); v += shx(v, 1); return v; }
DI float sigmoidf_(float x) { return 1.f / (1.f + __expf(-x)); }
DI float softplusf_(float x) { return fmaxf(x, 0.f) + log1pf(__expf(-fabsf(x))); }
DI int bid_() { return (int)blockIdx.x; }
DI f32x16 zero16() { f32x16 z; for (int i = 0; i < 16; ++i) z[i] = 0.f; return z; }

template <class F> DI void epi_iter(const f32x4 (&acc)[2][2][4][2], const Unit& u, int wr, int wc, int fr, int fq, F f) {
    const int row0 = u.pm * 256 + wr * 64 + fr, col0 = u.pn * 256 + wc * 32 + 8 * fq;
#pragma unroll
    for (int ai = 0; ai < 2; ++ai)
#pragma unroll
        for (int m = 0; m < 4; ++m)
#pragma unroll
            for (int bj = 0; bj < 2; ++bj) { f(row0 + ai * 128 + m * 16, col0 + bj * 128, acc[ai][bj][m][0], acc[ai][bj][m][1]); if ((m == 3) && bj) asm volatile("" ::: "memory"); }
}
template <int MODE  > struct EpiStore {
    static constexpr bool PERM = true, AFTER_DRAIN = false;
    bf16_t* O; int ldc; const float* SS;
    DI void operator()(const f32x4 (&acc)[2][2][4][2], const Unit& u, int wr, int wc, int fr, int fq) const {
        bf16_t* Op = O; const int ld = ldc; const float* ssp = SS;
        epi_iter(acc, u, wr, wc, fr, fq, [&](int row, int col, f32x4 v0, f32x4 v1) {
            if (MODE == 1) { const float rs = rsqrtf(ssp[row] * (1.f / 1024.f) + EPS); for (int e = 0; e < 4; ++e) { float a = fmaxf(v0[e], 0.f) * rs; v0[e] = a * a; float b = fmaxf(v1[e], 0.f) * rs; v1[e] = b * b; } }
            if (MODE == 2) { for (int e = 0; e < 4; ++e) { v0[e] = sigmoidf_(v0[e]); v1[e] = sigmoidf_(v1[e]); } }
            u32x4 w; w.x = pk2(v0[0], v0[1]); w.y = pk2(v0[2], v0[3]); w.z = pk2(v1[0], v1[1]); w.w = pk2(v1[2], v1[3]);
            *(u32x4*)(Op + (size_t)row * ld + col) = w;
        });
    }
};
struct EpiInProj {
    static constexpr bool PERM = true, AFTER_DRAIN = false;
    bf16_t* O; int ldc; int rlo, rhi; const float* rc; const float* rsn;
    DI void operator()(const f32x4 (&acc)[2][2][4][2], const Unit& u, int wr, int wc, int fr, int fq) const {
        bf16_t* Op = O; const int ld = ldc, lo = rlo, hi = rhi; const float* cp = rc; const float* sp = rsn;
        epi_iter(acc, u, wr, wc, fr, fq, [&](int row, int col, f32x4 v0, f32x4 v1) {
            if (col >= lo && col < hi) {
                const int i0 = ((col - lo) & 63) >> 1;
                const f32x4 c4 = *(const f32x4*)(cp + (size_t)row * 32 + i0), s4 = *(const f32x4*)(sp + (size_t)row * 32 + i0);
                const float sc = (col - lo) < 512 ? 0.125f * LOG2E : 1.f;
                for (int e = 0; e < 4; ++e) { const float y1 = (v0[e] * c4[e] - v1[e] * s4[e]) * sc, y2 = (v1[e] * c4[e] + v0[e] * s4[e]) * sc; v0[e] = y1; v1[e] = y2; }
            }
            u32x4 w; w.x = pk2(v0[0], v0[1]); w.y = pk2(v0[2], v0[3]); w.z = pk2(v1[0], v1[1]); w.w = pk2(v1[2], v1[3]);
            *(u32x4*)(Op + (size_t)row * ld + col) = w;
        });
    }
};
struct EpiResid {
    static constexpr bool PERM = true, AFTER_DRAIN = false;
    const float* Xi; float* Xo; bf16_t* Hb; float* SS;
    DI void operator()(const f32x4 (&acc)[2][2][4][2], const Unit& u, int wr, int wc, int fr, int fq) const {
        const float* xi = Xi; float* xo = Xo; bf16_t* hb = Hb; float* ssp = SS;
        const int row0 = u.pm * 256 + wr * 64 + fr, col0 = u.pn * 256 + wc * 32 + 8 * fq;
#pragma unroll
        for (int ai = 0; ai < 2; ++ai)
#pragma unroll
            for (int m = 0; m < 4; ++m) { const int row = row0 + ai * 128 + m * 16; float ss = 0.f;
#pragma unroll
                for (int bj = 0; bj < 2; ++bj) { const size_t o = (size_t)row * DM + col0 + bj * 128;
                    f32x4 a = *(const f32x4*)(xi + o), b = *(const f32x4*)(xi + o + 4);
                    a += acc[ai][bj][m][0]; b += acc[ai][bj][m][1];
                    *(f32x4*)(xo + o) = a; *(f32x4*)(xo + o + 4) = b;
                    if (hb) { u32x4 w; w.x = pk2(a[0], a[1]); w.y = pk2(a[2], a[3]); w.z = pk2(b[0], b[1]); w.w = pk2(b[2], b[3]); *(u32x4*)(hb + o) = w; }
                    ss += a[0] * a[0] + a[1] * a[1] + a[2] * a[2] + a[3] * a[3] + b[0] * b[0] + b[1] * b[1] + b[2] * b[2] + b[3] * b[3]; }
                if (ssp) { ss += shx(ss, 16); ss += shx(ss, 32); if (fq == 0) atomicAdd(ssp + row, ss); }
                if (m == 3) asm volatile("" ::: "memory"); }
    }
};
struct EpiPle {
    static constexpr bool PERM = true, AFTER_DRAIN = false;
    float* X; const bf16_t* G;
    DI void operator()(const f32x4 (&acc)[2][2][4][2], const Unit& u, int wr, int wc, int fr, int fq) const {
        float* x = X; const bf16_t* g = G;
        epi_iter(acc, u, wr, wc, fr, fq, [&](int row, int col, f32x4 v0, f32x4 v1) {
            const size_t o = (size_t)row * DM + col;
            f32x4 a = *(const f32x4*)(x + o), b = *(const f32x4*)(x + o + 4);
            const u32x4 gw = *(const u32x4*)(g + o);
            a[0] += v0[0] * bflo(gw.x); a[1] += v0[1] * bfhi(gw.x); a[2] += v0[2] * bflo(gw.y); a[3] += v0[3] * bfhi(gw.y);
            b[0] += v1[0] * bflo(gw.z); b[1] += v1[1] * bfhi(gw.z); b[2] += v1[2] * bflo(gw.w); b[3] += v1[3] * bfhi(gw.w);
            *(f32x4*)(x + o) = a; *(f32x4*)(x + o + 4) = b;
        });
    }
};
template <class Epi> DI void run_gemm(lptr lds, const bf16_t* A, const bf16_t* Bt, int N, int K, const Epi& E) {
    asm volatile("" : "+s"(N), "+s"(K));
    pg8::Gemm g{A, Bt, MTOK, N, K}; pg8::StaticOrder S; S.init(MTOK, N, (int)gridDim.x, (int)bid_());
    pg8::gemm_phase<Epi, pg8::StaticOrder, true, true>(lds, g, S, E);
}

struct RevOrder : pg8::StaticOrder {
    DI bool next(int i, Unit& u) const {
        const long Lf = (long)i * G + c; if (Lf >= nwg) return false;
        int wgid = nwg - 1 - (int)Lf; { const int q = nwg / pg8::NXCD, r = nwg % pg8::NXCD, xcd = wgid % pg8::NXCD, off = wgid / pg8::NXCD; wgid = (xcd < r ? xcd * (q + 1) : r * (q + 1) + (xcd - r) * q) + off; }
        const int nig = pg8::WGM * nN, gid = wgid / nig, fm = gid * pg8::WGM, gsz = (nM - fm) < pg8::WGM ? (nM - fm) : pg8::WGM;
        u.pm = fm + ((wgid % nig) % gsz); u.pn = (wgid % nig) / gsz; return true;
    }
};
template <class Epi> DI void run_gemm_rev(lptr lds, const bf16_t* A, const bf16_t* Bt, int N, int K, const Epi& E) {
    asm volatile("" : "+s"(N), "+s"(K));
    pg8::Gemm g{A, Bt, MTOK, N, K}; RevOrder S; S.init(MTOK, N, (int)gridDim.x, (int)bid_());
    pg8::gemm_phase<Epi, RevOrder, true, true>(lds, g, S, E);
}

DI void phase_prologue(const Params& p) {
    const int gtid = bid_() * 512 + tid_(), stride = gridDim.x * 512;
    const int* pos = (const int*)p.in[2];
    float* rc = (float*)(p.ws + WS_COS); float* rs = (float*)(p.ws + WS_SIN);
    for (int i = gtid; i < MTOK * 32; i += stride) {
        const int tok = i >> 5, f = i & 31;
        const float inv = exp2f(-(float)(2 * f) * (1.f / 64.f) * 13.287712379549449f);
        const float ang = (float)pos[tok] * inv;
        const float C1 = 0.15915494309189535f;
        const float rh = ang * C1; const float rl = fmaf(ang, C1, -rh);
        float fr = rh - rintf(rh); fr += rl;
        rc[i] = __builtin_amdgcn_cosf(fr); rs[i] = __builtin_amdgcn_sinf(fr);
    }
}

struct ConvJob { const float* W; bf16_t* Wt; const float* rs; int K, ldn, Nout, split; int rlo, rhi; };
DI void conv_tile(const ConvJob& J, int t, lptr lds) {
    const int tid = tid_(); const int nkt = J.K / 64;
    const int kt = t % nkt, nt = t / nkt; const int k0 = kt * 64, n0d = nt * 256, n0s = n0d + (n0d >= J.split ? 8 : 0);
#pragma unroll
    for (int it = 0; it < 8; ++it) { const int kr = it * 8 + (tid >> 6), nc = (tid & 63) * 4;
        int scol = n0s + nc;
        if (n0d >= J.rlo && n0d < J.rhi) { const int d = n0d + nc - J.rlo, jj = d & 63, chunk = jj >> 3; scol = J.rlo + (n0s - n0d) + (d & ~63) + ((jj & 4) ? 32 + 4 * chunk : 4 * chunk); }
        const f32x4 v = __builtin_nontemporal_load((const f32x4*)(J.W + (size_t)(k0 + kr) * J.ldn + scol));
        const float rsc = J.rs ? J.rs[k0 + kr] : 1.f;
        lst<f32x4>(lds, (kr * 260 + nc) * 4, v * rsc); }
    __syncthreads();
    { const int n = tid >> 1, kh = (tid & 1) * 32;
#pragma unroll
        for (int q = 0; q < 4; ++q) { float v[8];
            for (int e = 0; e < 8; ++e) v[e] = lld<float>(lds, ((kh + 8 * q + e) * 260 + n) * 4);
            u32x4 w; w.x = pk2(v[0], v[1]); w.y = pk2(v[2], v[3]); w.z = pk2(v[4], v[5]); w.w = pk2(v[6], v[7]);
            *(u32x4*)(J.Wt + (size_t)(n0d + n) * J.K + k0 + kh + 8 * q) = w; } }
    __syncthreads();
}

DI void phase_norm(const float* X, const float* nw, bf16_t* H, const float* Wg, int ldw, int col0, float* GATE, lptr lds) {
    const int tid = tid_(), wave = tid >> 6, lane = tid & 63;
    if (Wg) { for (int i = tid; i < 1024 * 8; i += 512) lst<float>(lds, 32768 + ((i & 7) * 1024 + (i >> 3)) * 4, Wg[(size_t)(i >> 3) * ldw + col0 + (i & 7)]); }
    __syncthreads();
    f32x4 wv[4];
#pragma unroll
    for (int k = 0; k < 4; ++k) wv[k] = *(const f32x4*)(nw + 4 * lane + 256 * k);
    for (int row = bid_() * 8 + wave; row < MTOK; row += gridDim.x * 8) {
        f32x4 x[4]; float ss = 0.f;
#pragma unroll
        for (int k = 0; k < 4; ++k) { x[k] = *(const f32x4*)(X + (size_t)row * DM + 4 * lane + 256 * k); ss += x[k][0] * x[k][0] + x[k][1] * x[k][1] + x[k][2] * x[k][2] + x[k][3] * x[k][3]; }
        ss = wave_sum(ss);
        const float rstd = rsqrtf(ss * (1.f / 1024.f) + EPS);
#pragma unroll
        for (int k = 0; k < 4; ++k) { for (int e = 0; e < 4; ++e) x[k][e] = x[k][e] * rstd * wv[k][e];
            u32x2 w; w.x = pk2(x[k][0], x[k][1]); w.y = pk2(x[k][2], x[k][3]); *(u32x2*)(H + (size_t)row * DM + 4 * lane + 256 * k) = w; }
        if (Wg) {
            float g[8]; for (int e = 0; e < 8; ++e) g[e] = 0.f;
#pragma unroll
            for (int k = 0; k < 4; ++k)
#pragma unroll
                for (int q = 0; q < 8; ++q) { const f32x4 w4 = lld<f32x4>(lds, 32768 + (q * 1024 + 4 * lane + 256 * k) * 4);
                    g[q] += x[k][0] * w4[0] + x[k][1] * w4[1] + x[k][2] * w4[2] + x[k][3] * w4[3]; }
            for (int e = 0; e < 8; ++e) g[e] = wave_sum(g[e]);
            if (lane == 0) { *(f32x4*)(GATE + (size_t)row * 8) = (f32x4){g[0], g[1], g[2], g[3]}; *(f32x4*)(GATE + (size_t)row * 8 + 4) = (f32x4){g[4], g[5], g[6], g[7]}; }
        }
    }
    __syncthreads();
}
DI void phase_final_norm(float* X, const float* nw) {
    const int tid = tid_(), wave = tid >> 6, lane = tid & 63;
    f32x4 wv[4];
#pragma unroll
    for (int k = 0; k < 4; ++k) wv[k] = *(const f32x4*)(nw + 4 * lane + 256 * k);
    for (int row = bid_() * 8 + wave; row < MTOK; row += gridDim.x * 8) {
        f32x4 x[4]; float ss = 0.f;
#pragma unroll
        for (int k = 0; k < 4; ++k) { x[k] = *(const f32x4*)(X + (size_t)row * DM + 4 * lane + 256 * k); ss += x[k][0] * x[k][0] + x[k][1] * x[k][1] + x[k][2] * x[k][2] + x[k][3] * x[k][3]; }
        ss = wave_sum(ss);
        const float rstd = rsqrtf(ss * (1.f / 1024.f) + EPS);
#pragma unroll
        for (int k = 0; k < 4; ++k) { for (int e = 0; e < 4; ++e) x[k][e] = x[k][e] * rstd * wv[k][e]; *(f32x4*)(X + (size_t)row * DM + 4 * lane + 256 * k) = x[k]; }
    }
}

DI void phase_rope(const Params& p) {
    bf16_t* P = (bf16_t*)(p.ws + WS_P); const float* rc = (const float*)(p.ws + WS_COS); const float* rs = (const float*)(p.ws + WS_SIN);
    const int tid = tid_(), wave = tid >> 6, lane = tid & 63;
    const int gidx = lane >> 2, sub = lane & 3;
    const int col = 2048 + (gidx >= 8 ? 512 : 0) + (gidx & 7) * 64 + sub * 8;
    const float sc = gidx >= 8 ? 1.f : 0.125f * LOG2E;
    for (int row = bid_() * 8 + wave; row < MTOK; row += gridDim.x * 8) {
        bf16_t* pr = P + (size_t)row * PE + col;
        const u32x4 a = *(const u32x4*)pr, b = *(const u32x4*)(pr + 32);
        const f32x4 c0 = *(const f32x4*)(rc + row * 32 + sub * 8), c1 = *(const f32x4*)(rc + row * 32 + sub * 8 + 4);
        const f32x4 s0 = *(const f32x4*)(rs + row * 32 + sub * 8), s1 = *(const f32x4*)(rs + row * 32 + sub * 8 + 4);
        float x1[8] = {bflo(a.x), bfhi(a.x), bflo(a.y), bfhi(a.y), bflo(a.z), bfhi(a.z), bflo(a.w), bfhi(a.w)};
        float x2[8] = {bflo(b.x), bfhi(b.x), bflo(b.y), bfhi(b.y), bflo(b.z), bfhi(b.z), bflo(b.w), bfhi(b.w)};
        float cc[8] = {c0[0], c0[1], c0[2], c0[3], c1[0], c1[1], c1[2], c1[3]}, sn[8] = {s0[0], s0[1], s0[2], s0[3], s1[0], s1[1], s1[2], s1[3]};
        float y1[8], y2[8];
        for (int e = 0; e < 8; ++e) { y1[e] = (x1[e] * cc[e] - x2[e] * sn[e]) * sc; y2[e] = (x2[e] * cc[e] + x1[e] * sn[e]) * sc; }
        u32x4 oa, ob; oa.x = pk2(y1[0], y1[1]); oa.y = pk2(y1[2], y1[3]); oa.z = pk2(y1[4], y1[5]); oa.w = pk2(y1[6], y1[7]);
        ob.x = pk2(y2[0], y2[1]); ob.y = pk2(y2[2], y2[3]); ob.z = pk2(y2[4], y2[5]); ob.w = pk2(y2[6], y2[7]);
        *(u32x4*)pr = oa; *(u32x4*)(pr + 32) = ob;
    }
}

DI void phase_cumsum(const Params& p, int j, lptr lds) {
    const float* GATE = (const float*)(p.ws + WS_GATE); float* CUM = (float*)(p.ws + WS_CUM); const float* bfg = p.in[18] + j * 8;
    const int tid = tid_();
    for (int s = bid_(); s < 64; s += gridDim.x) {
        const int b = s >> 3, h = s & 7; const float bias = bfg[h];
        float v[8]; float run = 0.f;
        for (int e = 0; e < 8; ++e) { const float f = GATE[((size_t)b * SEQ + tid * 8 + e) * 8 + h] + bias; run += -softplusf_(-f); v[e] = run; }
        float inc = run; const int lane = tid & 63, wv = tid >> 6;
        for (int d = 1; d < 64; d <<= 1) { const float t = __builtin_bit_cast(float, __builtin_amdgcn_ds_bpermute(((lane - d) & 63) << 2, __builtin_bit_cast(int, inc))); if (lane >= d) inc += t; }
        __syncthreads();
        if (lane == 63) lst<float>(lds, wv * 4, inc);
        __syncthreads();
        float off = inc - run;
        for (int q = 0; q < 8; ++q) { const float t = lld<float>(lds, q * 4); if (q < wv) off += t; }
        for (int e = 0; e < 8; ++e) CUM[(size_t)s * SEQ + tid * 8 + e] = off + v[e];
    }
    __syncthreads();
}

template <int DQK, bool FOX>
DI void attn_unit(const bf16_t* P, int pitch, int b, int qb, int qcol, int kcol, int vcol, bf16_t* Out, int opitch, int ocol, int gcol, const float* cum, lptr lds) {
    constexpr int KROWB = DQK * 2, KBUF = 64 * KROWB, VBUF = 64 * 256;
    constexpr int REG = KBUF + VBUF, OFF_K = 0, OFF_V = KBUF, OFF_C = 2 * REG;
    constexpr int NKS = DQK / 16;
    constexpr int NKD = KBUF / 8192;
    constexpr float QC = 0.08838834764831845f * LOG2E;
    const int tid = tid_(), w = __builtin_amdgcn_readfirstlane(tid >> 6), lane = tid & 63, r = lane & 31, h = lane >> 5;
    const size_t tokbase = (size_t)b * SEQ;
    const int q0 = qb * 256 + w * 32;
    bf16x8 qf[NKS];
#pragma unroll
    for (int ks = 0; ks < NKS; ++ks) {
        u32x4 qw = *(const u32x4*)(P + (tokbase + q0 + r) * pitch + qcol + 16 * ks + 8 * h);
        if (FOX) { qw.x = pk2(bflo(qw.x) * QC, bfhi(qw.x) * QC); qw.y = pk2(bflo(qw.y) * QC, bfhi(qw.y) * QC); qw.z = pk2(bflo(qw.z) * QC, bfhi(qw.z) * QC); qw.w = pk2(bflo(qw.w) * QC, bfhi(qw.w) * QC); }
        qf[ks] = __builtin_bit_cast(bf16x8, qw);
    }
    const int ntiles = 4 * (qb + 1);
    f32x16 O[4]; for (int d = 0; d < 4; ++d) O[d] = zero16();
    float m_run = NEGBIG, l_run = 0.f;
    float creg = 0.f;
    size_t kgo[NKD], vgo[2];
#pragma unroll
    for (int i = 0; i < NKD; ++i) {
        int row, c;
        if (DQK == 128) { row = 4 * (2 * w + i) + (lane >> 4); c = (lane & 15) ^ (row & 15); }
        else            { row = 8 * w + (lane >> 3);           c = (lane & 7) ^ ((row >> 1) & 7); }
        kgo[i] = (tokbase + row) * pitch + kcol + c * 8;
    }
#pragma unroll
    for (int i = 0; i < 2; ++i) { const int row = 4 * (2 * w + i) + (lane >> 4), c = (lane & 15) ^ (4 * (row & 3)); vgo[i] = (tokbase + row) * pitch + vcol + c * 8; }
    int kx[NKS], vx[4];
#pragma unroll
    for (int ks = 0; ks < NKS; ++ks) kx[ks] = (DQK == 128) ? (r * 256 + (((2 * ks + h) ^ (r & 15)) << 4)) : (r * 128 + (((2 * ks + h) ^ ((r >> 1) & 7)) << 4));
    { const int q4 = (lane & 15) >> 2, p4 = lane & 3, g1 = (lane >> 4) & 1;
#pragma unroll
      for (int d = 0; d < 4; ++d) vx[d] = (4 * h + q4) * 256 + ((4 * (d ^ q4) + 2 * g1 + (p4 >> 1)) << 4) + ((p4 & 1) << 3); }
    const int cfo = 16 * h;
    auto dma = [&](int kt, auto BUFC) {
        constexpr int buf = decltype(BUFC)::value;
        const size_t step = (size_t)kt * 64 * pitch;
#pragma unroll
        for (int i = 0; i < NKD; ++i) __builtin_amdgcn_global_load_lds((const unsigned*)(P + kgo[i] + step), (LAS unsigned*)(lds + OFF_K + buf * REG + (NKD * w + i) * 1024), 16, 0, 0);
#pragma unroll
        for (int i = 0; i < 2; ++i) __builtin_amdgcn_global_load_lds((const unsigned*)(P + vgo[i] + step), (LAS unsigned*)(lds + OFF_V + buf * REG + (2 * w + i) * 1024), 16, 0, 0);
    };
    auto body = [&](int it, auto BUFC) {
        constexpr int buf = decltype(BUFC)::value;
        const int kt = ntiles - 1 - it;
        const bool more = (kt > 0);
        if (more) { dma(kt - 1, std::integral_constant<int, 1 - buf>{}); if (FOX) { if (tid < 64) creg = -cum[(kt - 1) * 64 + tid] * LOG2E; } }
        if (64 * kt <= q0 + 31) {
            f32x16 pp[2];
#pragma unroll
            for (int t2 = 0; t2 < 2; ++t2) {
                if (FOX) {
#pragma unroll
                    for (int g = 0; g < 4; ++g) { const f32x4 ck = lld<f32x4>(lds, OFF_C + buf * 256 + cfo + (32 * t2 + 8 * g) * 4);
                        pp[t2][4 * g] = ck[0]; pp[t2][4 * g + 1] = ck[1]; pp[t2][4 * g + 2] = ck[2]; pp[t2][4 * g + 3] = ck[3]; }
                } else pp[t2] = zero16();
#pragma unroll
                for (int ks = 0; ks < NKS; ++ks) { const bf16x8 kf = lld<bf16x8>(lds + (OFF_K + buf * REG + 32 * t2 * KROWB), kx[ks]); pp[t2] = mfma32(kf, qf[ks], pp[t2]); } }
            const bool diag = (64 * kt + 63 > q0);
            if (diag) {
#pragma unroll
                for (int t2 = 0; t2 < 2; ++t2)
#pragma unroll
                    for (int i = 0; i < 16; ++i) { const int key = 64 * kt + 32 * t2 + crow(i, h); if (key > q0 + r) pp[t2][i] = NEGBIG; }
            }
            float mx = NEGBIG;
#pragma unroll
            for (int t2 = 0; t2 < 2; ++t2)
#pragma unroll
                for (int i = 0; i < 16; ++i) mx = fmaxf(mx, pp[t2][i]);
            mx = fmaxf(mx, shx(mx, 32));
            const float m_new = fmaxf(m_run, mx);
            const float alpha = __builtin_amdgcn_exp2f(m_run - m_new);
            const bool changed = __builtin_amdgcn_ballot_w64(m_new > m_run) != 0ull;
            m_run = m_new;
            float ls = 0.f;
#pragma unroll
            for (int t2 = 0; t2 < 2; ++t2)
#pragma unroll
                for (int i = 0; i < 16; ++i) { const float e = __builtin_amdgcn_exp2f(pp[t2][i] - m_new); pp[t2][i] = e; ls += e; }
            l_run = l_run * alpha + ls;
            if (changed) {
#pragma unroll
                for (int d = 0; d < 4; ++d) O[d] *= alpha;
            }
            bf16x8 pf[4];
#pragma unroll
            for (int s = 0; s < 4; ++s) pf[s] = pack8(pp[s >> 1], s & 1);
#pragma unroll
            for (int d = 0; d < 4; ++d)
#pragma unroll
                for (int s = 0; s < 4; ++s) {
                    const s16x4 lo = vtr(lds + (OFF_V + buf * REG + (16 * s) * 256) + vx[d]), hi = vtr(lds + (OFF_V + buf * REG + (16 * s + 8) * 256) + vx[d]);
                    const bf16x8 vf = __builtin_shufflevector(lo, hi, 0, 1, 2, 3, 4, 5, 6, 7);
                    O[d] = mfma32(vf, pf[s], O[d]);
                }
        }
        if (FOX) { if (more && tid < 64) lst<float>(lds, OFF_C + (1 - buf) * 256 + tid * 4, creg); }
        asm volatile("s_waitcnt vmcnt(0)" ::: "memory");
        __syncthreads();
    };
    dma(ntiles - 1, std::integral_constant<int, 0>{});
    if (FOX) { if (tid < 64) lst<float>(lds, OFF_C + tid * 4, -cum[(ntiles - 1) * 64 + tid] * LOG2E); }
    asm volatile("s_waitcnt vmcnt(0)" ::: "memory");
    __syncthreads();
#pragma unroll 1
    for (int kt = 0; kt < ntiles; kt += 2) { body(kt, std::integral_constant<int, 0>{}); body(kt + 1, std::integral_constant<int, 1>{}); }
    const float l = l_run + shx(l_run, 32);
    const float inv = 1.f / l;
    const size_t tok = tokbase + q0 + r;
#pragma unroll
    for (int d = 0; d < 4; ++d)
#pragma unroll
        for (int g = 0; g < 4; ++g) {
            const int dv = 32 * d + 8 * g + 4 * h;
            float v[4]; for (int e = 0; e < 4; ++e) v[e] = O[d][4 * g + e] * inv;
            if (FOX) { const u32x2 gw = *(const u32x2*)(P + tok * pitch + gcol + dv);
                v[0] *= sigmoidf_(bflo(gw.x)); v[1] *= sigmoidf_(bfhi(gw.x)); v[2] *= sigmoidf_(bflo(gw.y)); v[3] *= sigmoidf_(bfhi(gw.y)); }
            u32x2 o; o.x = pk2(v[0], v[1]); o.y = pk2(v[2], v[3]);
            *(u32x2*)(Out + tok * opitch + ocol + dv) = o;
        }
}

template <int C, int END, class F> DI void for_const(F& f) { if constexpr (C < END) { f(std::integral_constant<int, C>{}); for_const<C + 1, END>(f); } }
constexpr int T1_Q = 0, T1_K = 17408, T1_V = 34816, T1_L = 52224, T1_GC = 69632, T1_BETA = T1_GC + 256, T1_EGC = T1_GC + 512, T1_STRIDE = 70656;
constexpr float QSCALE = 0.08838834764831845f;
DI void g1_team(const Params& p, int j, int unit, lptr lds) {
    const bf16_t* P = (const bf16_t*)(p.ws + WS_P);
    const float* GATE = (const float*)(p.ws + WS_GATE);
    const float* cw = p.in[7] + (size_t)j * 4 * 1536;
    const int b = unit >> 8, h = (unit >> 6) & 3, n = unit & 63;
    const int tid = tid_(), lt = tid & 255, lw = __builtin_amdgcn_readfirstlane((tid >> 6) & 3), lane = tid & 63, r = lane & 31, hh = lane >> 5;
    unsigned char* rec = p.ws + WS_REC + (size_t)unit * 65536;
    unsigned char* qkrec = p.ws + WS_QK + (size_t)unit * 8192;
    if (lt < 64) {
        const size_t tok = (size_t)b * SEQ + 64 * n + lt;
        const float bb = GATE[tok * 8 + h], aa = GATE[tok * 8 + 4 + h];
        const float beta = sigmoidf_(bb);
        float g = -__expf(p.in[8][j * 4 + h]) * softplusf_(aa + p.in[9][j * 4 + h]);
        for (int d = 1; d < 64; d <<= 1) { const float t = __builtin_bit_cast(float, __builtin_amdgcn_ds_bpermute(((lane - d) & 63) << 2, __builtin_bit_cast(int, g))); if (lane >= d) g += t; }
        lst<float>(lds, T1_GC + lt * 4, g); lst<float>(lds, T1_BETA + lt * 4, beta); lst<float>(lds, T1_EGC + lt * 4, __expf(g));
    }
    if (lw < 3) {
        const int rb = lt / 48, cg = lt % 48, part = cg >> 4, sub = cg & 15;
        const int col = part * 512 + h * 128 + sub * 8, t0 = 64 * n + rb * 16;
        f32x4 wl[4][2];
#pragma unroll
        for (int i = 0; i < 4; ++i) { wl[i][0] = *(const f32x4*)(cw + i * 1536 + col); wl[i][1] = *(const f32x4*)(cw + i * 1536 + col + 4); }
        u32x4 xr[19];
#pragma unroll
        for (int q = 0; q < 19; ++q) { const int tt = t0 - 3 + q; const int tc = tt < 0 ? 0 : tt;
            u32x4 v = *(const u32x4*)(P + ((size_t)b * SEQ + tc) * PE + col);
            if (tt < 0) v = (u32x4){0u, 0u, 0u, 0u};
            xr[q] = v; }
#pragma unroll
        for (int i = 0; i < 16; ++i) {
            float acc[8]; for (int e = 0; e < 8; ++e) acc[e] = 0.f;
#pragma unroll
            for (int tp = 0; tp < 4; ++tp) { const u32x4 x = xr[i + tp]; const f32x4 w0 = wl[tp][0], w1 = wl[tp][1];
                acc[0] += w0[0] * bflo(x.x); acc[1] += w0[1] * bfhi(x.x); acc[2] += w0[2] * bflo(x.y); acc[3] += w0[3] * bfhi(x.y);
                acc[4] += w1[0] * bflo(x.z); acc[5] += w1[1] * bfhi(x.z); acc[6] += w1[2] * bflo(x.w); acc[7] += w1[3] * bfhi(x.w); }
            float ss = 0.f;
            for (int e = 0; e < 8; ++e) { acc[e] = acc[e] * sigmoidf_(acc[e]); ss += acc[e] * acc[e]; }
            ss += shx(ss, 1); ss += shx(ss, 2); ss += shx(ss, 4); ss += shx(ss, 8);
            if (part < 2) { const float rn = rsqrtf(ss + EPS); for (int e = 0; e < 8; ++e) acc[e] *= rn; }
            u32x4 o; o.x = pk2(acc[0], acc[1]); o.y = pk2(acc[2], acc[3]); o.z = pk2(acc[4], acc[5]); o.w = pk2(acc[6], acc[7]);
            lst<u32x4>(lds, part * 17408 + (rb * 16 + i) * 272 + sub * 16, o);
        }
    }
    __syncthreads();
    {
        const int ct = lw >> 1, st = lw & 1;
        if (st <= ct) {
            f32x16 acc = zero16();
#pragma unroll
            for (int ks = 0; ks < 8; ++ks) { const bf16x8 a = lld<bf16x8>(lds, T1_K + (32 * ct + r) * 272 + (16 * ks + 8 * hh) * 2), bq = lld<bf16x8>(lds, T1_K + (32 * st + r) * 272 + (16 * ks + 8 * hh) * 2); acc = mfma32(a, bq, acc); }
            const int s = 32 * st + r; const float gcs = lld<float>(lds, T1_GC + s * 4);
#pragma unroll
            for (int i = 0; i < 16; ++i) { const int c = 32 * ct + crow(i, hh);
                const float val = (s < c) ? acc[i] * lld<float>(lds, T1_BETA + c * 4) * __expf(lld<float>(lds, T1_GC + c * 4) - gcs) : 0.f;
                lst<float>(lds, T1_L + (c * 68 + s) * 4, val); }
        }
    }
    {
        const int st = lw >> 1, ct = lw & 1;
        f32x16 acc = zero16();
#pragma unroll
        for (int ks = 0; ks < 8; ++ks) { const bf16x8 a = lld<bf16x8>(lds, T1_K + (32 * st + r) * 272 + (16 * ks + 8 * hh) * 2), bq = lld<bf16x8>(lds, T1_Q + (32 * ct + r) * 272 + (16 * ks + 8 * hh) * 2); acc = mfma32(a, bq, acc); }
        const int c = 32 * ct + r; const float gcc = lld<float>(lds, T1_GC + c * 4);
#pragma unroll
        for (int i = 0; i < 16; ++i) { const int s = 32 * st + crow(i, hh);
            acc[i] = (s <= c) ? acc[i] * QSCALE * __expf(gcc - lld<float>(lds, T1_GC + s * 4)) : 0.f; }
#pragma unroll
        for (int half = 0; half < 2; ++half) { const bf16x8 f = pack8(acc, half); const int ksp = 2 * st + half;
            *(bf16x8*)(qkrec + ((ct * 4 + ksp) * 64 + lane) * 16) = f; }
    }
    {
        const int w2 = lw;
#pragma unroll
        for (int q = 0; q < 4; ++q) {
            const int rt = q & 1, ks = 2 * w2 + (q >> 1); const int c = 32 * rt + r; const float sc = QSCALE * lld<float>(lds, T1_EGC + c * 4);
            const u32x2 a = lld<u32x2>(lds, T1_Q + c * 272 + (16 * ks + 4 * hh) * 2), bq = lld<u32x2>(lds, T1_Q + c * 272 + (16 * ks + 8 + 4 * hh) * 2);
            u32x4 o; o.x = pk2(bflo(a.x) * sc, bfhi(a.x) * sc); o.y = pk2(bflo(a.y) * sc, bfhi(a.y) * sc); o.z = pk2(bflo(bq.x) * sc, bfhi(bq.x) * sc); o.w = pk2(bflo(bq.y) * sc, bfhi(bq.y) * sc);
            *(u32x4*)(rec + 16384 + ((rt * 8 + ks) * 64 + lane) * 16) = o;
        }
        const float gl = lld<float>(lds, T1_GC + 63 * 4);
#pragma unroll
        for (int ksp = 0; ksp < 4; ++ksp) {
            float v[8];
#pragma unroll
            for (int jx = 0; jx < 8; ++jx) { const int c = krow(ksp, hh, jx); v[jx] = bf2f(lld<unsigned short>(lds, T1_K + c * 272 + (32 * w2 + r) * 2)) * __expf(gl - lld<float>(lds, T1_GC + c * 4)); }
            u32x4 o; o.x = pk2(v[0], v[1]); o.y = pk2(v[2], v[3]); o.z = pk2(v[4], v[5]); o.w = pk2(v[6], v[7]);
            *(u32x4*)(rec + 32768 + ((w2 * 4 + ksp) * 64 + lane) * 16) = o;
        }
    }
    __syncthreads();
    if (lw == 0) {
        float x[64];
        x[0] = (lane == 0) ? 1.f : 0.f;
        f32x4 lo[8], nlo[8], hi[8];
        lo[0] = lld<f32x4>(lds, T1_L + (1 * 68) * 4);
        auto row = [&](auto CC) {
            constexpr int c = decltype(CC)::value;
            constexpr int nch = (c + 3) / 4, nnx = (c + 4) / 4;
#pragma unroll
            for (int s4 = 8; s4 < 16; ++s4) if (s4 < nch) hi[s4 - 8] = lld<f32x4>(lds, T1_L + (c * 68 + 4 * s4) * 4);
            if (c + 1 < 64) {
#pragma unroll
                for (int s4 = 0; s4 < 8; ++s4) if (s4 < nnx) nlo[s4] = lld<f32x4>(lds, T1_L + ((c + 1) * 68 + 4 * s4) * 4);
            }
            __builtin_amdgcn_sched_barrier(0);
            float a = (c == lane) ? 1.f : 0.f;
            f32x4 pa = {0.f, 0.f, 0.f, 0.f};
#pragma unroll
            for (int s4 = 0; s4 < 8; ++s4) if (s4 < nch) {
#pragma unroll
                for (int e = 0; e < 4; ++e) if (4 * s4 + e < c) pa[e] += lo[s4][e] * x[4 * s4 + e]; }
#pragma unroll
            for (int s4 = 8; s4 < 16; ++s4) if (s4 < nch) {
#pragma unroll
                for (int e = 0; e < 4; ++e) if (4 * s4 + e < c) pa[e] += hi[s4 - 8][e] * x[4 * s4 + e]; }
            a -= (pa[0] + pa[1]) + (pa[2] + pa[3]);
            x[c] = a;
            __builtin_amdgcn_sched_barrier(0);
#pragma unroll
            for (int s4 = 0; s4 < 8; ++s4) if (s4 < nnx) lo[s4] = nlo[s4];
        };
        for_const<1, 64>(row);
        const float bt = lld<float>(lds, T1_BETA + lane * 4), bte = bt * lld<float>(lds, T1_EGC + lane * 4);
#pragma unroll
        for (int c = 0; c < 64; ++c) {
            lst<unsigned short>(lds, T1_Q + c * 144 + lane * 2, (unsigned short)(pk2(x[c] * bt, 0.f) & 0xffffu));
            lst<unsigned short>(lds, T1_L + c * 144 + lane * 2, (unsigned short)(pk2(x[c] * bte, 0.f) & 0xffffu));
        }
    }
    __syncthreads();
    {
        const int dvt = lw, q4 = (lane & 15) >> 2, p4 = lane & 3, g1 = (lane >> 4) & 1;
        const int boff = (8 * hh + q4) * 272 + (32 * dvt + 16 * g1 + 4 * p4) * 2;
        f32x16 wacc[2];
#pragma unroll
        for (int rt = 0; rt < 2; ++rt) {
            f32x16 ua = zero16(); wacc[rt] = zero16();
#pragma unroll
            for (int ks = 0; ks < 4; ++ks) {
                const bf16x8 au = lld<bf16x8>(lds, T1_Q + (32 * rt + r) * 144 + (16 * ks + 8 * hh) * 2), aw = lld<bf16x8>(lds, T1_L + (32 * rt + r) * 144 + (16 * ks + 8 * hh) * 2);
                const s16x4 vlo = vtr(lds + T1_V + (16 * ks) * 272 + boff), vhi = vtr(lds + T1_V + (16 * ks + 4) * 272 + boff);
                const s16x4 klo = vtr(lds + T1_K + (16 * ks) * 272 + boff), khi = vtr(lds + T1_K + (16 * ks + 4) * 272 + boff);
                ua = mfma32(au, __builtin_shufflevector(vlo, vhi, 0, 1, 2, 3, 4, 5, 6, 7), ua);
                wacc[rt] = mfma32(aw, __builtin_shufflevector(klo, khi, 0, 1, 2, 3, 4, 5, 6, 7), wacc[rt]);
            }
            u32x4 o0, o1;
            o0.x = pk2(ua[0], ua[1]); o0.y = pk2(ua[2], ua[3]); o0.z = pk2(ua[4], ua[5]); o0.w = pk2(ua[6], ua[7]);
            o1.x = pk2(ua[8], ua[9]); o1.y = pk2(ua[10], ua[11]); o1.z = pk2(ua[12], ua[13]); o1.w = pk2(ua[14], ua[15]);
            unsigned char* up = rec + 49152 + ((rt * 4 + dvt) * 64 + lane) * 32;
            *(u32x4*)up = o0; *(u32x4*)(up + 16) = o1;
        }
        __syncthreads();
#pragma unroll
        for (int rt = 0; rt < 2; ++rt)
#pragma unroll
            for (int i = 0; i < 16; ++i) lst<unsigned short>(lds, T1_Q + (32 * rt + crow(i, hh)) * 272 + (32 * dvt + r) * 2, (unsigned short)(pk2(wacc[rt][i], 0.f) & 0xffffu));
    }
    __syncthreads();
    {
#pragma unroll
        for (int q = 0; q < 4; ++q) { const int f = lw * 4 + q, rt = f & 1, ks = f >> 1; const int c = 32 * rt + r;
            const u32x2 a = lld<u32x2>(lds, T1_Q + c * 272 + (16 * ks + 4 * hh) * 2), bq = lld<u32x2>(lds, T1_Q + c * 272 + (16 * ks + 8 + 4 * hh) * 2);
            u32x4 o; o.x = a.x; o.y = a.y; o.z = bq.x; o.w = bq.y;
            *(u32x4*)(rec + ((rt * 8 + ks) * 64 + lane) * 16) = o; }
        if (lt == 0) ((float*)(p.ws + WS_GL))[unit] = lld<float>(lds, T1_EGC + 63 * 4);
    }
    __syncthreads();
}

constexpr int SC_BUF = 57344;
DI void scan_unit(const Params& p, int b, int h, lptr lds) {
    bf16_t* P = (bf16_t*)(p.ws + WS_P);
    const int tid = tid_(), w = tid >> 6, lane = tid & 63, r = lane & 31, hh = lane >> 5;
    const int bh = b * 4 + h;
    const unsigned char* rec0 = p.ws + WS_REC + (size_t)bh * 64 * 65536;
    const unsigned char* qk0 = p.ws + WS_QK + (size_t)bh * 64 * 8192;
    const float* GL = (const float*)(p.ws + WS_GL) + bh * 64;
    auto stage = [&](int n) {
        const int lt = tid - 256; const lptr dst = lds + (n & 1) * SC_BUF;
        const unsigned char* src = rec0 + (size_t)n * 65536; const unsigned char* qsrc = qk0 + (size_t)n * 8192;
        u32x4 v[14];
#pragma unroll
        for (int i = 0; i < 12; ++i) v[i] = *(const u32x4*)(src + (lt + 256 * i) * 16);
#pragma unroll
        for (int i = 0; i < 2; ++i) v[12 + i] = *(const u32x4*)(qsrc + (lt + 256 * i) * 16);
#pragma unroll
        for (int i = 0; i < 12; ++i) lst<u32x4>(dst, (lt + 256 * i) * 16, v[i]);
#pragma unroll
        for (int i = 0; i < 2; ++i) lst<u32x4>(dst, 49152 + (lt + 256 * i) * 16, v[12 + i]);
    };
    f32x16 S[4]; for (int d = 0; d < 4; ++d) S[d] = zero16();
    if (w >= 4) stage(0);
#pragma unroll 1
    for (int n = 0; n < 64; ++n) {
        __syncthreads();
        if (w < 4) {
            const lptr buf = lds + (n & 1) * SC_BUF; const int dvt = w;
            const unsigned char* urec = rec0 + (size_t)n * 65536 + 49152;
            u32x4 ur[2][2];
#pragma unroll
            for (int rt = 0; rt < 2; ++rt) { const unsigned char* up = urec + ((rt * 4 + dvt) * 64 + lane) * 32; ur[rt][0] = *(const u32x4*)up; ur[rt][1] = *(const u32x4*)(up + 16); }
            const float gl = GL[n];
            f32x16 ws[2], o[2]; ws[0] = zero16(); ws[1] = zero16(); o[0] = zero16(); o[1] = zero16();
#pragma unroll
            for (int ks = 0; ks < 8; ++ks) { const bf16x8 sf = pack8(S[ks >> 1], ks & 1);
#pragma unroll
                for (int rt = 0; rt < 2; ++rt) { const bf16x8 wf = lld<bf16x8>(buf, ((rt * 8 + ks) * 64 + lane) * 16), qf = lld<bf16x8>(buf, 16384 + ((rt * 8 + ks) * 64 + lane) * 16);
                    ws[rt] = mfma32(wf, sf, ws[rt]); o[rt] = mfma32(qf, sf, o[rt]); } }
            f32x16 vn[2];
#pragma unroll
            for (int rt = 0; rt < 2; ++rt) {
                const unsigned uw[8] = {ur[rt][0].x, ur[rt][0].y, ur[rt][0].z, ur[rt][0].w, ur[rt][1].x, ur[rt][1].y, ur[rt][1].z, ur[rt][1].w};
#pragma unroll
                for (int q = 0; q < 8; ++q) { vn[rt][2 * q] = bflo(uw[q]) - ws[rt][2 * q]; vn[rt][2 * q + 1] = bfhi(uw[q]) - ws[rt][2 * q + 1]; }
            }
            bf16x8 vf[4];
#pragma unroll
            for (int ksp = 0; ksp < 4; ++ksp) vf[ksp] = pack8(vn[ksp >> 1], ksp & 1);
#pragma unroll
            for (int rt = 0; rt < 2; ++rt)
#pragma unroll
                for (int ksp = 0; ksp < 4; ++ksp) o[rt] = mfma32(lld<bf16x8>(buf, 49152 + ((rt * 4 + ksp) * 64 + lane) * 16), vf[ksp], o[rt]);
#pragma unroll
            for (int d = 0; d < 4; ++d) { S[d] *= gl;
#pragma unroll
                for (int ksp = 0; ksp < 4; ++ksp) S[d] = mfma32(lld<bf16x8>(buf, 32768 + ((d * 4 + ksp) * 64 + lane) * 16), vf[ksp], S[d]); }
#pragma unroll
            for (int rt = 0; rt < 2; ++rt)
#pragma unroll
                for (int i = 0; i < 16; ++i) { const size_t tok = (size_t)b * SEQ + 64 * n + 32 * rt + crow(i, hh);
                    P[tok * PE + 1024 + h * 128 + 32 * dvt + r] = (bf16_t)(pk2(o[rt][i], 0.f) & 0xffffu); }
        } else if (n + 1 < 64) stage(n + 1);
    }
    __syncthreads();
}

DI void phase_post(const Params& p, int L) {
    const int j = L >> 1;
    const bf16_t* P = (const bf16_t*)(p.ws + WS_P); bf16_t* O = (bf16_t*)(p.ws + WS_O);
    const int tid = tid_(), wave = tid >> 6, lane = tid & 63;
    const float lambda_init = 0.8f - 0.6f * __expf(-0.3f * (float)L);
    const float s1 = wave_sum(p.in[11][j * 64 + lane] * p.in[12][j * 64 + lane]), s2 = wave_sum(p.in[13][j * 64 + lane] * p.in[14][j * 64 + lane]);
    const float lam = expf(s1) - expf(s2) + lambda_init;
    const bool isa = lane < 32; const int d0 = (lane & 7) * 16;
    float nw[16];
    { const float* src = isa ? (p.in[10] + j * 128 + d0) : (p.in[15] + j * 128 + d0); for (int e = 0; e < 16; ++e) nw[e] = src[e] * (isa ? 1.f : (1.f - lambda_init)); }
    for (int row = bid_() * 8 + wave; row < MTOK; row += gridDim.x * 8) {
        const bf16_t* pr = P + (size_t)row * PE;
        float o[16];
        if (isa) { const u32x4 a = *(const u32x4*)(pr + 1024 + 16 * lane), bq = *(const u32x4*)(pr + 1024 + 16 * lane + 8);
            const unsigned uw[8] = {a.x, a.y, a.z, a.w, bq.x, bq.y, bq.z, bq.w};
            for (int q = 0; q < 8; ++q) { o[2 * q] = bflo(uw[q]); o[2 * q + 1] = bfhi(uw[q]); } }
        else { const int l2 = lane - 32;
            const u32x4 a = *(const u32x4*)(pr + 16 * l2), bq = *(const u32x4*)(pr + 16 * l2 + 8), c = *(const u32x4*)(pr + 512 + 16 * l2), d = *(const u32x4*)(pr + 512 + 16 * l2 + 8);
            const unsigned u1[8] = {a.x, a.y, a.z, a.w, bq.x, bq.y, bq.z, bq.w}, u2[8] = {c.x, c.y, c.z, c.w, d.x, d.y, d.z, d.w};
            for (int q = 0; q < 8; ++q) { o[2 * q] = bflo(u1[q]) - lam * bflo(u2[q]); o[2 * q + 1] = bfhi(u1[q]) - lam * bfhi(u2[q]); } }
        float ss = 0.f; for (int e = 0; e < 16; ++e) ss += o[e] * o[e];
        ss += shx(ss, 1); ss += shx(ss, 2); ss += shx(ss, 4);
        const float rn = rsqrtf(ss * (1.f / 128.f) + EPS);
        float g[16];
        if (isa) { const u32x4 a = *(const u32x4*)(pr + 1536 + 16 * lane), bq = *(const u32x4*)(pr + 1536 + 16 * lane + 8);
            const unsigned uw[8] = {a.x, a.y, a.z, a.w, bq.x, bq.y, bq.z, bq.w};
            for (int q = 0; q < 8; ++q) { const float z0 = bflo(uw[q]), z1 = bfhi(uw[q]); g[2 * q] = z0 * sigmoidf_(z0); g[2 * q + 1] = z1 * sigmoidf_(z1); } }
        else for (int e = 0; e < 16; ++e) g[e] = 1.f;
        for (int e = 0; e < 16; ++e) o[e] = o[e] * rn * nw[e] * g[e];
        u32x4 w0, w1; w0.x = pk2(o[0], o[1]); w0.y = pk2(o[2], o[3]); w0.z = pk2(o[4], o[5]); w0.w = pk2(o[6], o[7]);
        w1.x = pk2(o[8], o[9]); w1.y = pk2(o[10], o[11]); w1.z = pk2(o[12], o[13]); w1.w = pk2(o[14], o[15]);
        *(u32x4*)(O + (size_t)row * DM + 16 * lane) = w0; *(u32x4*)(O + (size_t)row * DM + 16 * lane + 8) = w1;
    }
}

DI int next_unit(int* ctr, lptr lds) {
    __syncthreads();
    if (tid_() == 0) lst<int>(lds, LDS_UNIT_WORD, atomicAdd(ctr, 1));
    __syncthreads();
    return lld<int>(lds, LDS_UNIT_WORD);
}


#define XB_TMO      128
#define XB_XCNT(j)  (256  + 64 * (j))
#define XB_XSUB(j)  (1280 + 64 * (j))
#define XB_XGEN(j)  (2304 + 64 * (j))
#define XB_TOP      3328
#define XB_TOPGEN   3392
#define XCD_BAR_WORDS 3456
#define XB_SPIN_CAP (1u << 22)
DI unsigned xb_ld(unsigned* p)              { return __hip_atomic_load(p, __ATOMIC_RELAXED, __HIP_MEMORY_SCOPE_AGENT); }
DI unsigned xb_add(unsigned* p, unsigned v) { return __hip_atomic_fetch_add(p, v, __ATOMIC_RELAXED, __HIP_MEMORY_SCOPE_AGENT); }
DI unsigned xb_xcc_id() { return (unsigned)__builtin_amdgcn_s_getreg((3 << 11) | 20) & 0xFu; }
#define XB_SPIN(cond, bar) do { unsigned _sp = 0; while (cond) { __builtin_amdgcn_s_sleep(1); \
    if ((++_sp & 255u) == 0u) { if (xb_ld(&(bar)[XB_TMO])) break; if (_sp > XB_SPIN_CAP) { atomicAdd(&(bar)[XB_TMO], 1u); break; } } } } while (0)
struct XcdBarrier { unsigned* bar; unsigned x; volatile LAS unsigned* st; };
DI XcdBarrier xcd_barrier_post(unsigned* bar, volatile LAS unsigned* st) {
    XcdBarrier b; b.bar = bar; b.x = xb_xcc_id(); b.st = st;
    if (threadIdx.x == 0) (void)xb_add(&bar[XB_XCNT(b.x)], 1u);
    return b;
}
DI void xcd_barrier_complete(unsigned* bar, unsigned x, unsigned& nloc, unsigned& nx) {
    const unsigned G = gridDim.x * gridDim.y * gridDim.z;
    unsigned sum, cnt, mine, sp = 0u;
    for (;;) {
        sum = 0u; cnt = 0u; mine = 0u;
#pragma unroll
        for (unsigned j = 0; j < 16; ++j) { const unsigned c = xb_ld(&bar[XB_XCNT(j)]); sum += c; cnt += (c > 0u) ? 1u : 0u; mine = (j == x) ? c : mine; }
        if (sum == G) break;
        __builtin_amdgcn_s_sleep(1);
        if ((++sp & 255u) == 0u) { if (xb_ld(&bar[XB_TMO])) break; if (sp > XB_SPIN_CAP) { atomicAdd(&bar[XB_TMO], 1u); break; } }
    }
    nloc = mine > 0u ? mine : 1u; nx = cnt > 0u ? cnt : 1u;
}
DI void xcd_barrier(const XcdBarrier& b) {
    asm volatile("s_waitcnt vmcnt(0)" ::: "memory");
    __syncthreads();
    if (threadIdx.x == 0) {
        unsigned* bar = b.bar;
        __builtin_amdgcn_s_waitcnt(0);
        unsigned nloc = b.st[0], nx = b.st[1];
        if (nloc == 0u) { xcd_barrier_complete(bar, b.x, nloc, nx); b.st[0] = nloc; b.st[1] = nx; }
        const unsigned old = xb_add(&bar[XB_XSUB(b.x)], 1u);
        const unsigned gen = old / nloc;
        if (old + 1u == (gen + 1u) * nloc) {
            __builtin_amdgcn_fence(__ATOMIC_RELEASE, "agent");
            asm volatile("s_waitcnt vmcnt(0)" ::: "memory");
            const unsigned og = xb_add(&bar[XB_TOP], 1u);
            const unsigned tg = og / nx;
            if (og + 1u == (tg + 1u) * nx) xb_add(&bar[XB_TOPGEN], 1u);
            else XB_SPIN(xb_ld(&bar[XB_TOPGEN]) == tg, bar);
            __builtin_amdgcn_fence(__ATOMIC_ACQUIRE, "agent");
            xb_add(&bar[XB_XGEN(b.x)], 1u);
            asm volatile("s_waitcnt vmcnt(0)" ::: "memory");
        } else {
            XB_SPIN(xb_ld(&bar[XB_XGEN(b.x)]) == gen, bar);
            __builtin_amdgcn_fence(__ATOMIC_ACQUIRE, "agent");
            asm volatile("s_waitcnt vmcnt(0)" ::: "memory");
        }
    }
    __syncthreads();
}

#ifndef PROBE
#define PROBE 0
#endif
#define GSYNC() do { xcd_barrier(xb); if (PROBE == 3) xcd_barrier(xb); } while (0)
__global__ void __launch_bounds__(512) mega(Params p) {
    extern __shared__ __attribute__((aligned(16))) unsigned char smem_raw[];
    const lptr lds = (lptr)smem_raw;
    cg::grid_group grid = cg::this_grid();
    float* X = p.out;
    bf16_t* H = (bf16_t*)(p.ws + WS_H); bf16_t* Pb = (bf16_t*)(p.ws + WS_P); bf16_t* O = (bf16_t*)(p.ws + WS_O); bf16_t* PB = (bf16_t*)(p.ws + WS_PB);
    float* GATE = (float*)(p.ws + WS_GATE);
    bf16_t* Wt_in = (bf16_t*)(p.ws + WS_W + W_IN); bf16_t* Wt_out = (bf16_t*)(p.ws + WS_W + W_OUT); bf16_t* Wt_up = (bf16_t*)(p.ws + WS_W + W_UP);
    bf16_t* Wt_down = (bf16_t*)(p.ws + WS_W + W_DOWN); bf16_t* Wt_ple = (bf16_t*)(p.ws + WS_W + W_PLE); bf16_t* Wt_gate = (bf16_t*)(p.ws + WS_W + W_GATE);
    int* ctr = (int*)(p.ws + WS_CTL);
    float* SSb = (float*)(p.ws + WS_SS);

    if (tid_() == 0) { lst<unsigned>(lds, LDS_UNIT_WORD + 16, 0u); lst<unsigned>(lds, LDS_UNIT_WORD + 20, 0u); }
    __syncthreads();
    const XcdBarrier xb = xcd_barrier_post((unsigned*)(p.ws + WS_CTL + 4096), (volatile LAS unsigned*)(lds + LDS_UNIT_WORD + 16));
    phase_prologue(p);
    if (p.ws == nullptr) grid.sync();
    GSYNC();
#pragma unroll 1
    for (int L = 0; L < 4; ++L) {
        const bool even = !(L & 1); const int j = L >> 1;
        const float* Xin = (L == 0) ? p.in[0] : X;
        const float* Win = even ? (p.in[6] + (size_t)j * 1024 * EVEN_IN) : (p.in[17] + (size_t)j * 1024 * ODD_IN);
        const int ldw = even ? EVEN_IN : ODD_IN; const int NIN = even ? PE : PO;
        for (int rep1 = 0; rep1 < (PROBE == 5 ? 2 : 1); ++rep1) {
        phase_norm(Xin, p.in[3] + L * 1024, H, Win, ldw, even ? 2048 : 4096, GATE, lds);
        {
            const int n_in = 16 * (NIN / 256);
            const int c1 = n_in, c2 = c1 + 64, c3 = c2 + 256, c4 = c3 + 256, c5 = c4 + 16, c6 = c5 + 64;
            for (int g = bid_(); g < c6; g += gridDim.x) {
                ConvJob J;
                if (g < c1)      { J = ConvJob{Win, Wt_in, nullptr, 1024, ldw, NIN, even ? 2048 : (1 << 30), even ? 2048 : 0, even ? 3072 : 0}; conv_tile(J, g, lds); }
                else if (g < c2) { J = ConvJob{(even ? p.in[16] : p.in[19]) + (size_t)j * 1024 * 1024, Wt_out, nullptr, 1024, 1024, 1024, 1 << 30, 0, 0}; conv_tile(J, g - c1, lds); }
                else if (g < c3) { J = ConvJob{p.in[20] + (size_t)L * 1024 * 4096, Wt_up, p.in[4] + L * 1024, 1024, 4096, 4096, 1 << 30, 0, 0}; conv_tile(J, g - c2, lds); }
                else if (g < c4) { J = ConvJob{p.in[21] + (size_t)L * 4096 * 1024, Wt_down, nullptr, 4096, 1024, 1024, 1 << 30, 0, 0}; conv_tile(J, g - c3, lds); }
                else if (g < c5) { J = ConvJob{p.in[22] + (size_t)L * 256 * 1024, Wt_ple, nullptr, 256, 1024, 1024, 1 << 30, 0, 0}; conv_tile(J, g - c4, lds); }
                else             { J = ConvJob{p.in[23] + (size_t)L * 1024 * 1024, Wt_gate, nullptr, 1024, 1024, 1024, 1 << 30, 0, 0}; conv_tile(J, g - c5, lds); }
            }
            for (int i = bid_() * 512 + tid_(); i < MTOK; i += gridDim.x * 512) SSb[i] = 0.f;
        }
        { const float* ps = p.in[1] + (size_t)L * MTOK * 256;
            for (size_t i = (size_t)bid_() * 512 + tid_(); i < (size_t)MTOK * 256 / 4; i += (size_t)gridDim.x * 512) { const f32x4 v = __builtin_nontemporal_load((const f32x4*)(ps + i * 4)); u32x2 w; w.x = pk2(v[0], v[1]); w.y = pk2(v[2], v[3]); *(u32x2*)(PB + i * 4) = w; } }
        }
        GSYNC();
        if (!even) phase_cumsum(p, j, lds);
        { EpiInProj E{Pb, NIN, even ? 2048 : 0, even ? 3072 : 0, (const float*)(p.ws + WS_COS), (const float*)(p.ws + WS_SIN)}; run_gemm(lds, H, Wt_in, NIN, 1024, E); }
        GSYNC();
        if (even) {
            { const int team = __builtin_amdgcn_readfirstlane(tid_() >> 8);
              for (int u2 = bid_(); u2 < 1024; u2 += gridDim.x) g1_team(p, j, 2047 - (2 * u2 + team), lds + team * T1_STRIDE); }
            GSYNC();
            for (int rep = 0; rep < (PROBE == 2 ? 2 : 1); ++rep) for (;;) { const int u = next_unit(ctr + L + 8 * rep, lds); if (u >= 32 + 1024) break;
                if (u < 32) scan_unit(p, u >> 2, u & 3, lds);
                else { const int a = u - 32, qb = 15 - (a >> 6), idx = a & 63, b = idx >> 3, hd = (idx >> 1) & 3, mp = idx & 1;
                    attn_unit<64, false>(Pb, PE, b, qb, 2048 + hd * 128 + mp * 64, 2560 + hd * 128 + mp * 64, 3072 + hd * 128, Pb, PE, mp * 512 + hd * 128, 0, nullptr, lds); } }
            GSYNC();
            for (int rep4 = 0; rep4 < (PROBE == 4 ? 2 : 1); ++rep4) phase_post(p, L);
        } else {
            for (int rep = 0; rep < (PROBE == 2 ? 2 : 1); ++rep) for (;;) { const int u = next_unit(ctr + L + 8 * rep, lds); if (u >= 1024) break;
                const int qb = 15 - (u >> 6), idx = u & 63, b = idx >> 3, hd = idx & 7;
                attn_unit<128, true>(Pb, PO, b, qb, hd * 128, 1024 + hd * 128, 2048 + hd * 128, O, DM, hd * 128, 3072 + hd * 128, (const float*)(p.ws + WS_CUM) + (size_t)idx * SEQ, lds); }
        }
        GSYNC();
        if (PROBE == 1) { EpiStore<0> E{Pb, 1024, nullptr}; run_gemm(lds, O, Wt_out, 1024, 1024, E); }
        { EpiResid E{Xin, X, H, SSb}; run_gemm(lds, O, Wt_out, 1024, 1024, E); }
        GSYNC();
        for (int rep = 0; rep < (PROBE == 1 ? 2 : 1); ++rep) { EpiStore<1> E{Pb, 4096, SSb}; run_gemm(lds, H, Wt_up, 4096, 1024, E); }
        GSYNC();
        if (PROBE == 1) { EpiStore<0> E{O, 1024, nullptr}; run_gemm(lds, Pb, Wt_down, 1024, 4096, E); }
        { EpiResid E{X, X, H, nullptr}; run_gemm_rev(lds, Pb, Wt_down, 1024, 4096, E); }
        GSYNC();
        { EpiStore<2> E{O, 1024, nullptr}; run_gemm(lds, H, Wt_gate, 1024, 1024, E); }
        if (PROBE == 1) { EpiStore<0> E{H, 1024, nullptr}; run_gemm(lds, PB, Wt_ple, 1024, 256, E); }
        { EpiPle E{X, O}; run_gemm(lds, PB, Wt_ple, 1024, 256, E); }
        GSYNC();
    }
    phase_final_norm(X, p.in[5]);
}

extern "C" void kernel_launch(void* const* d_in, const int* in_sizes, int n_in, void* d_out, int out_size, void* d_ws, size_t ws_size, hipStream_t stream) {
    static int grid_blocks = 0;
    if (!grid_blocks) {
        int dev = 0, cus = 0, per_cu = 0;
        hipGetDevice(&dev);
        hipDeviceGetAttribute(&cus, hipDeviceAttributeMultiprocessorCount, dev);
        hipFuncSetAttribute((const void*)mega, hipFuncAttributeMaxDynamicSharedMemorySize, LDS_BYTES);
        hipOccupancyMaxActiveBlocksPerMultiprocessor(&per_cu, (const void*)mega, 512, LDS_BYTES);
        if (per_cu < 1) per_cu = 1;
        grid_blocks = cus * per_cu;
        if (ws_size < WS_END) fprintf(stderr, "kernel_launch: workspace too small: %zu < %zu\n", ws_size, (size_t)WS_END);
    }
    (void)hipMemsetAsync((char*)d_ws + WS_CTL, 0, 65536, stream);
    Params p{};
    for (int i = 0; i < 24; ++i) p.in[i] = (const float*)d_in[i];
    p.out = (float*)d_out; p.ws = (unsigned char*)d_ws;
    void* args[] = {&p};
    hipError_t e = hipLaunchCooperativeKernel((const void*)mega, dim3(grid_blocks), dim3(512), args, LDS_BYTES, stream);
    if (e != hipSuccess) fprintf(stderr, "cooperative launch failed: %s (grid %d)\n", hipGetErrorString(e), grid_blocks);
}
```
